# Optimizing an MI355X kernel written in HIP

```python
import math
import jax, jax.numpy as jnp
from jax import lax
import numpy as np

D_MODEL = 1024
BATCH = 32
SEQ = 2048
DEPTH = 1

CHUNK = 64
GMLP_BLOCK = 128
GMLP_GROUPS = 4
GMLP_WIDTH = D_MODEL
GMLP_GROUP_DIM = GMLP_WIDTH // GMLP_GROUPS
SB_HEADS = 16
SB_HEAD_DIM = 64
SB_WIDTH = SB_HEADS * SB_HEAD_DIM
SB_QBLOCK = 128
D_FF = 2816
N_BRANCHES = 2
D_IN = 2 * GMLP_WIDTH + 3 * SB_WIDTH + N_BRANCHES * D_MODEL
EPS = 1e-6

kernel_name = "hybrid_gmlp_stickbreaking_macaron_block"


def rmsnorm(x, g):
    xf = x.astype(jnp.float32)
    y = xf * lax.rsqrt(jnp.mean(xf * xf, axis=-1, keepdims=True) + EPS)
    return (y * g.astype(jnp.float32)).astype(x.dtype)


def layernorm(x, g, b):
    xf = x.astype(jnp.float32)
    mu = jnp.mean(xf, axis=-1, keepdims=True)
    var = jnp.mean(jnp.square(xf - mu), axis=-1, keepdims=True)
    y = (xf - mu) * lax.rsqrt(var + EPS)
    return (y * g.astype(jnp.float32) + b.astype(jnp.float32)).astype(x.dtype)


def swiglu(x, w_gate, w_up, w_down):
    return (jax.nn.silu(x @ w_gate) * (x @ w_up)) @ w_down


def gmlp_spatial_gating(a, ln_g, ln_b, w_s, b_s):
    bsz, seq, _ = a.shape
    nblk = seq // GMLP_BLOCK
    u, v = jnp.split(a, 2, axis=-1)
    u = u.reshape(bsz, nblk, GMLP_BLOCK, GMLP_GROUPS, GMLP_GROUP_DIM)
    v = v.reshape(bsz, nblk, GMLP_BLOCK, GMLP_GROUPS, GMLP_GROUP_DIM)
    v = layernorm(v, ln_g, ln_b)
    pos = jnp.arange(GMLP_BLOCK)
    mask = (pos[None, :] // CHUNK) <= (pos[:, None] // CHUNK)
    w_masked = jnp.where(mask[None], w_s, jnp.zeros((), w_s.dtype))
    s_mix = jnp.einsum('gts,bnsgc->bntgc', w_masked, v) + jnp.transpose(b_s)[None, None, :, :, None]
    return (u * s_mix).reshape(bsz, seq, GMLP_WIDTH)


def stick_breaking_attention(q, k, v):
    q = jnp.transpose(q, (0, 2, 1, 3))
    k = jnp.transpose(k, (0, 2, 1, 3))
    v = jnp.transpose(v, (0, 2, 1, 3))
    seq = q.shape[2]
    scale = 1.0 / math.sqrt(SB_HEAD_DIM)
    outs = []
    for blk in range(seq // SB_QBLOCK):
        q0 = blk * SB_QBLOCK
        kend = q0 + SB_QBLOCK
        qb = q[:, :, q0:kend]
        kb = k[:, :, :kend]
        vb = v[:, :, :kend]
        z = jnp.einsum('bhtd,bhsd->bhts', qb, kb).astype(jnp.float32) * scale
        t_idx = q0 + jnp.arange(SB_QBLOCK)[:, None]
        s_idx = jnp.arange(kend)[None, :]
        causal = s_idx < t_idx
        log_keep = jnp.where(causal, -jax.nn.softplus(z), 0.0)
        log_w = jax.nn.log_sigmoid(z) + lax.cumsum(log_keep, axis=3, reverse=True) - log_keep
        w = jnp.where(causal, jnp.exp(log_w), 0.0)
        outs.append(jnp.einsum('bhts,bhsd->bhtd', w.astype(vb.dtype), vb))
    o = jnp.concatenate(outs, axis=2)
    return jnp.transpose(o, (0, 2, 1, 3))


def setup_inputs(seed: int = 0) -> dict:
    key = jax.random.key(seed)
    ks = jax.random.split(key, 24)
    f32 = jnp.float32

    def nrm(k, shape, fan_in):
        return jax.random.normal(k, shape, f32) * (fan_in ** -0.5)

    def gain(k, shape):
        return 1.0 + 0.05 * jax.random.normal(k, shape, f32)

    L = DEPTH
    return {
        "x": jax.random.normal(ks[0], (BATCH, SEQ, D_MODEL), f32),
        "ff1_norm": gain(ks[1], (L, D_MODEL)),
        "ff1_w_gate": nrm(ks[2], (L, D_MODEL, D_FF), D_MODEL),
        "ff1_w_up": nrm(ks[3], (L, D_MODEL, D_FF), D_MODEL),
        "ff1_w_down": nrm(ks[4], (L, D_FF, D_MODEL), D_FF),
        "mix_norm": gain(ks[5], (L, D_MODEL)),
        "w_in": nrm(ks[6], (L, D_MODEL, D_IN), D_MODEL),
        "b_gate": 0.05 * jax.random.normal(ks[7], (L, N_BRANCHES * D_MODEL), f32),
        "gmlp_ln_g": gain(ks[8], (L, GMLP_GROUPS, GMLP_GROUP_DIM)),
        "gmlp_ln_b": 0.05 * jax.random.normal(ks[9], (L, GMLP_GROUPS, GMLP_GROUP_DIM), f32),
        "gmlp_w_s": nrm(ks[10], (L, GMLP_GROUPS, GMLP_BLOCK, GMLP_BLOCK), GMLP_BLOCK),
        "gmlp_b_s": 1.0 + 0.1 * jax.random.normal(ks[11], (L, GMLP_GROUPS, GMLP_BLOCK), f32),
        "w_branch_a": nrm(ks[12], (L, GMLP_WIDTH, D_MODEL), GMLP_WIDTH),
        "w_branch_b": nrm(ks[13], (L, SB_WIDTH, D_MODEL), SB_WIDTH),
        "w_out": nrm(ks[14], (L, D_MODEL, D_MODEL), D_MODEL),
        "ff2_norm": gain(ks[15], (L, D_MODEL)),
        "ff2_w_gate": nrm(ks[16], (L, D_MODEL, D_FF), D_MODEL),
        "ff2_w_up": nrm(ks[17], (L, D_MODEL, D_FF), D_MODEL),
        "ff2_w_down": nrm(ks[18], (L, D_FF, D_MODEL), D_FF),
        "final_norm": gain(ks[19], (D_MODEL,)),
    }


def reference(x, ff1_norm, ff1_w_gate, ff1_w_up, ff1_w_down, mix_norm, w_in, b_gate,
              gmlp_ln_g, gmlp_ln_b, gmlp_w_s, gmlp_b_s, w_branch_a, w_branch_b, w_out,
              ff2_norm, ff2_w_gate, ff2_w_up, ff2_w_down, final_norm):
    bsz, seq, _ = x.shape
    splits = [2 * GMLP_WIDTH, 2 * GMLP_WIDTH + SB_WIDTH, 2 * GMLP_WIDTH + 2 * SB_WIDTH,
              2 * GMLP_WIDTH + 3 * SB_WIDTH]
    for l in range(DEPTH):
        x = x + 0.5 * swiglu(rmsnorm(x, ff1_norm[l]), ff1_w_gate[l], ff1_w_up[l], ff1_w_down[l])

        h = rmsnorm(x, mix_norm[l])
        proj = h @ w_in[l]
        a_in, q, k, v, g_logits = jnp.split(proj, splits, axis=-1)
        y_a = gmlp_spatial_gating(jax.nn.gelu(a_in, approximate=False),
                                  gmlp_ln_g[l], gmlp_ln_b[l], gmlp_w_s[l], gmlp_b_s[l])
        q = q.reshape(bsz, seq, SB_HEADS, SB_HEAD_DIM)
        k = k.reshape(bsz, seq, SB_HEADS, SB_HEAD_DIM)
        v = v.reshape(bsz, seq, SB_HEADS, SB_HEAD_DIM)
        y_b = stick_breaking_attention(q, k, v).reshape(bsz, seq, SB_WIDTH)
        gates = jax.nn.sigmoid(g_logits + b_gate[l])
        g_a, g_b = jnp.split(gates, 2, axis=-1)
        merged = g_a * (y_a @ w_branch_a[l]) + g_b * (y_b @ w_branch_b[l])
        x = x + merged @ w_out[l]

        x = x + 0.5 * swiglu(rmsnorm(x, ff2_norm[l]), ff2_w_gate[l], ff2_w_up[l], ff2_w_down[l])
    return rmsnorm(x, final_norm)
```

```cpp
#include <hip/hip_runtime.h>
#include <hip/hip_cooperative_groups.h>
#include <cstdio>
#include <cstdint>
namespace cg = cooperative_groups;
namespace pg8 {
#define PG8_LAS __attribute__((address_space(3)))
typedef unsigned short bf16_t;
typedef short bf16x8 __attribute__((ext_vector_type(8)));
typedef float f32x4 __attribute__((ext_vector_type(4)));
typedef unsigned u32x4 __attribute__((ext_vector_type(4)));
constexpr int BM = 256, BK = 64, HALF = 128, HTB = HALF * BK * 2  , STAGE_BYTES = 8 * HTB, NXCD = 8, WGM = 8;

__host__ __device__ __forceinline__ int lds_byte(int r, int c) { const int st = (r >> 4) * 2 + (c >> 5), rr = r & 15, cc = c & 31, ob = rr * 64 + cc * 2; return st * 1024 + (ob ^ (((ob >> 9) & 1) << 5)); }
__host__ __device__ __forceinline__ void stage_rc(int b, int& R, int& C) { const int st = b / 1024, sb = b % 1024, swz = sb ^ (((sb >> 9) & 1) << 5); R = (st >> 1) * 16 + swz / 64; C = (st & 1) * 32 + (swz % 64) / 2; }
__host__ __device__ __forceinline__ int perm32(int rho) { const int n = rho >> 4, i = rho & 15; return 8 * (i >> 2) + 4 * n + (i & 3); }

struct Unit { int pm, pn; };
struct Gemm { const bf16_t* A; const bf16_t* Bt; int M, N, K; };

struct StaticOrder {
    int nM, nN, nwg, G, c;
    __host__ __device__ void init(int M, int N, int G_, int c_) { nM = M / BM; nN = N / BM; nwg = nM * nN; G = G_; c = c_; }
    __host__ __device__ bool next(int i, Unit& u) const {
        const long L = (long)i * G + c; if (L >= nwg) return false;
        int wgid = (int)L; { const int q = nwg / NXCD, r = nwg % NXCD, xcd = wgid % NXCD, off = wgid / NXCD; wgid = (xcd < r ? xcd * (q + 1) : r * (q + 1) + (xcd - r) * q) + off; }
        const int nig = WGM * nN, gid = wgid / nig, fm = gid * WGM, gsz = (nM - fm) < WGM ? (nM - fm) : WGM;
        u.pm = fm + ((wgid % nig) % gsz); u.pn = (wgid % nig) / gsz; return true;
    }
    __device__ __forceinline__ void a_ready(const Unit&) const {}
    __device__ __forceinline__ void done(const Unit&) const {}
};

typedef float cvt_f32x2 __attribute__((ext_vector_type(2))); typedef __bf16 cvt_bf16x2 __attribute__((ext_vector_type(2)));
__device__ __forceinline__ unsigned cvt_pk_bf16(float lo, float hi) { const cvt_f32x2 v = {lo, hi}; const cvt_bf16x2 b = __builtin_convertvector(v, cvt_bf16x2); return __builtin_bit_cast(unsigned, b); }
typedef float f32x2 __attribute__((ext_vector_type(2)));
__device__ __forceinline__ f32x2 gelu_pk(f32x2 v) {
    const f32x2 av = __builtin_elementwise_abs(v), d = av * 0.2316418882f + 1.0f;
    f32x2 t; t.x = __builtin_amdgcn_rcpf(d.x); t.y = __builtin_amdgcn_rcpf(d.y);
    f32x2 q = t * 0.5307027145f + (-0.7265760135f); q = q * t + 0.7107068705f; q = q * t + (-0.142248368f); q = q * t + 0.127414796f; q = q * t;
    const f32x2 s = (v * v) * (-0.72134752044f);
    f32x2 e; e.x = __builtin_amdgcn_exp2f(s.x); e.y = __builtin_amdgcn_exp2f(s.y);
    const f32x2 m = v * (q * e), r = v - m;
    f32x2 o; o.x = v.x < 0.f ? m.x : r.x; o.y = v.y < 0.f ? m.y : r.y; return o;
}

__device__ __forceinline__ float fast_sigmoid(float x) { return __builtin_amdgcn_rcpf(1.0f + __builtin_amdgcn_exp2f(-1.4426950408889634f * x)); }
__device__ __forceinline__ f32x2 sigmoid_pk(f32x2 x) { const f32x2 t = x * (-1.4426950408889634f); f32x2 e; e.x = __builtin_amdgcn_exp2f(t.x); e.y = __builtin_amdgcn_exp2f(t.y); const f32x2 d = e + 1.0f; f32x2 r; r.x = __builtin_amdgcn_rcpf(d.x); r.y = __builtin_amdgcn_rcpf(d.y); return r; }
__device__ __forceinline__ float bf_lo(unsigned w) { return __uint_as_float(w << 16); }
__device__ __forceinline__ float bf_hi(unsigned w) { return __uint_as_float(w & 0xffff0000u); }
struct EpiSwiglu {
    static constexpr bool PERM = true, AFTER_DRAIN = false;
    bf16_t* O; int ldc;
    __device__ __forceinline__ void operator()(const f32x4 (&acc)[2][2][4][2], const Unit& u, int wr, int wc, int fr, int fq) const {
        const int row0 = u.pm * BM + wr * 64 + fr, col0 = u.pn * HALF + wc * 32 + 8 * fq;
#pragma unroll
        for (int ai = 0; ai < 2; ++ai)
#pragma unroll
            for (int m = 0; m < 4; ++m) {
                bf16_t* rowp = O + (size_t)(row0 + ai * HALF + m * 16) * ldc + col0;
                f32x2 h[4];
#pragma unroll
                for (int n = 0; n < 2; ++n)
#pragma unroll
                    for (int e = 0; e < 2; ++e) { const f32x2 g = (f32x2){acc[ai][0][m][n][2 * e], acc[ai][0][m][n][2 * e + 1]}, up = (f32x2){acc[ai][1][m][n][2 * e], acc[ai][1][m][n][2 * e + 1]}; h[n * 2 + e] = (g * sigmoid_pk(g)) * up; }
                u32x4 w; w.x = cvt_pk_bf16(h[0].x, h[0].y); w.y = cvt_pk_bf16(h[1].x, h[1].y); w.z = cvt_pk_bf16(h[2].x, h[2].y); w.w = cvt_pk_bf16(h[3].x, h[3].y);
                *(u32x4*)rowp = w;
            }
    }
};
struct EpiResid {
    static constexpr bool PERM = false, AFTER_DRAIN = false;
    const float* base; float* out; int ldc; float alpha;
    __device__ __forceinline__ void operator()(const f32x4 (&acc)[2][2][4][2], const Unit& u, int wr, int wc, int fr, int fq) const {
        const int row0 = u.pm * BM + wr * 64 + fr, col0 = u.pn * BM + wc * 32 + 4 * fq;
#pragma unroll
        for (int ai = 0; ai < 2; ++ai)
#pragma unroll
            for (int m = 0; m < 4; ++m) {
                const size_t off = (size_t)(row0 + ai * HALF + m * 16) * ldc + col0;
#pragma unroll
                for (int bj = 0; bj < 2; ++bj)
#pragma unroll
                    for (int n = 0; n < 2; ++n) { const f32x4 b = *(const f32x4*)(base + off + bj * HALF + n * 16); *(f32x4*)(out + off + bj * HALF + n * 16) = b + acc[ai][bj][m][n] * alpha; }
            }
    }
};
template <int MODE, bool BASE_BF16> struct EpiResidNorm {
    static constexpr bool PERM = true, AFTER_DRAIN = false, TOUCH = false;
    const bf16_t* baseb; const float* rstd_in; void* dst; float* aux; float alpha; float* xbuf; unsigned* cnt; PG8_LAS unsigned char* tl;
    __device__ __forceinline__ void operator()(f32x4 (&acc)[2][2][4][2], const Unit& u, int wr, int wc, int fr, int fq) const {
        static_assert(BASE_BF16, "the residual base is the tile-major bf16 stream");
        int tix = threadIdx.x; asm volatile("" : "+v"(tix));
        const int lane = tix & 63, wid = __builtin_amdgcn_readfirstlane(tix >> 6);
        PG8_LAS float* P = (PG8_LAS float*)tl; PG8_LAS float* S = (PG8_LAS float*)(tl + 4096);
        const int row0 = u.pm * BM + wr * 64 + fr, col0 = u.pn * BM + wc * 32 + 8 * fq;
        const size_t toff = ((size_t)(u.pm * 4 + u.pn) << 16) + (size_t)((wr * 64 + fr) * 256 + wc * 32 + 8 * fq);
#pragma unroll
        for (int ai = 0; ai < 2; ++ai)
#pragma unroll
            for (int m = 0; m < 4; ++m) {
                float s = 0.f; const float rin = __builtin_amdgcn_rcpf(rstd_in[row0 + ai * HALF + m * 16]);
#pragma unroll
                for (int bj = 0; bj < 2; ++bj) { const u32x4 w = *(const u32x4*)(baseb + toff + (size_t)((ai * HALF + m * 16) * 256 + bj * HALF));
                    const f32x4 b0 = (f32x4){bf_lo(w.x), bf_hi(w.x), bf_lo(w.y), bf_hi(w.y)} * rin, b1 = (f32x4){bf_lo(w.z), bf_hi(w.z), bf_lo(w.w), bf_hi(w.w)} * rin;
                    const f32x4 v0 = b0 + acc[ai][bj][m][0] * alpha, v1 = b1 + acc[ai][bj][m][1] * alpha; acc[ai][bj][m][0] = v0; acc[ai][bj][m][1] = v1;
                    s += ((v0[0] * v0[0] + v0[1] * v0[1]) + (v0[2] * v0[2] + v0[3] * v0[3])) + ((v1[0] * v1[0] + v1[1] * v1[1]) + (v1[2] * v1[2] + v1[3] * v1[3])); }
                s += __shfl_xor(s, 16); s += __shfl_xor(s, 32);
                if (fq == 0) P[(ai * HALF + wr * 64 + m * 16 + fr) * 4 + wc] = s;
                if (m & 1) asm volatile("" ::: "memory");
            }
        asm volatile("s_waitcnt lgkmcnt(0)" ::: "memory"); __builtin_amdgcn_s_barrier(); asm volatile("" ::: "memory");
        const int row = wid * 32 + (lane & 31);
        float* slot = xbuf + ((size_t)(u.pm * BM + row) * 4);
        if (lane < 32) { const f32x4 p = *(const PG8_LAS f32x4*)(P + row * 4); __hip_atomic_store(slot + u.pn, (p[0] + p[1]) + (p[2] + p[3]), __ATOMIC_RELAXED, __HIP_MEMORY_SCOPE_AGENT); }
        asm volatile("s_waitcnt vmcnt(0)" ::: "memory");
        unsigned* c = cnt + 16 * u.pm;
        if (lane == 0) __hip_atomic_fetch_add(c, 1u, __ATOMIC_RELAXED, __HIP_MEMORY_SCOPE_AGENT);
        if (wid == 0) {
            unsigned sp = 0;
            while ((unsigned)__builtin_amdgcn_readfirstlane(__hip_atomic_load(c, __ATOMIC_RELAXED, __HIP_MEMORY_SCOPE_AGENT)) < 32u) { __builtin_amdgcn_s_sleep(2); if (++sp > (1u << 22)) break; }
            __builtin_amdgcn_fence(__ATOMIC_ACQUIRE, "agent");
        }
        asm volatile("s_waitcnt vmcnt(0) lgkmcnt(0)" ::: "memory"); __builtin_amdgcn_s_barrier(); asm volatile("" ::: "memory");
        if (lane < 32) { const float a = __hip_atomic_load(slot + 0, __ATOMIC_RELAXED, __HIP_MEMORY_SCOPE_AGENT), b = __hip_atomic_load(slot + 1, __ATOMIC_RELAXED, __HIP_MEMORY_SCOPE_AGENT),
                                     cc = __hip_atomic_load(slot + 2, __ATOMIC_RELAXED, __HIP_MEMORY_SCOPE_AGENT), d = __hip_atomic_load(slot + 3, __ATOMIC_RELAXED, __HIP_MEMORY_SCOPE_AGENT);
            const float rs = __builtin_amdgcn_rsqf(((a + b) + (cc + d)) * (1.0f / 1024.0f) + 1e-6f); S[row] = rs;
            if (MODE == 0 && u.pn == 0) aux[u.pm * BM + row] = rs; }
        asm volatile("s_waitcnt lgkmcnt(0)" ::: "memory"); __builtin_amdgcn_s_barrier(); asm volatile("" ::: "memory");
        f32x4 gv[2][2];
#pragma unroll
        for (int bj = 0; bj < 2; ++bj)
#pragma unroll
            for (int n = 0; n < 2; ++n) gv[bj][n] = (MODE == 1) ? *(const f32x4*)(aux + col0 + bj * HALF + n * 4) : (f32x4){1.f, 1.f, 1.f, 1.f};
#pragma unroll
        for (int ai = 0; ai < 2; ++ai)
#pragma unroll
            for (int m = 0; m < 4; ++m) {
                const float rs = S[ai * HALF + wr * 64 + m * 16 + fr]; const size_t off = (size_t)(row0 + ai * HALF + m * 16) * 1024 + col0;
#pragma unroll
                for (int bj = 0; bj < 2; ++bj) {
                    if (MODE == 1) { float* out = (float*)dst; *(f32x4*)(out + off + bj * HALF) = acc[ai][bj][m][0] * rs * gv[bj][0]; *(f32x4*)(out + off + bj * HALF + 4) = acc[ai][bj][m][1] * rs * gv[bj][1]; }
                    else { const f32x4 y0 = acc[ai][bj][m][0] * rs, y1 = acc[ai][bj][m][1] * rs; u32x4 w; w.x = cvt_pk_bf16(y0[0], y0[1]); w.y = cvt_pk_bf16(y0[2], y0[3]); w.z = cvt_pk_bf16(y1[0], y1[1]); w.w = cvt_pk_bf16(y1[2], y1[3]);
                        *(u32x4*)((bf16_t*)dst + toff + (size_t)((ai * HALF + m * 16) * 256 + bj * HALF)) = w; } }
                if (m & 1) asm volatile("" ::: "memory");
            }
    }
};
struct EpiNull { static constexpr bool PERM = true, AFTER_DRAIN = false; float* sink;
    __device__ __forceinline__ void operator()(f32x4 (&acc)[2][2][4][2], const Unit& u, int wr, int wc, int fr, int fq) const { f32x4 t = {0.f, 0.f, 0.f, 0.f};
#pragma unroll
        for (int a = 0; a < 2; ++a)
#pragma unroll
            for (int b = 0; b < 2; ++b)
#pragma unroll
                for (int m = 0; m < 4; ++m)
#pragma unroll
                    for (int n = 0; n < 2; ++n) t += acc[a][b][m][n];
        if (t[0] + t[1] + t[2] + t[3] == 12345.678f) sink[0] = t[0]; } };
template <int KIND> struct EpiProj {
    static constexpr bool PERM = true, AFTER_DRAIN = false;
    bf16_t *d0, *d1, *d2, *d3, *d4; const float* bias; float qscale;
    __device__ __forceinline__ void operator()(const f32x4 (&acc)[2][2][4][2], const Unit& u, int wr, int wc, int fr, int fq) const {
        const int seg = u.pn >> 2, colt = (u.pn & 3) * BM;
        bf16_t* dst = seg == 0 ? d0 : seg == 1 ? d1 : seg == 2 ? d2 : seg == 3 ? d3 : d4;
        const int row0 = u.pm * BM + wr * 64 + fr, col0 = colt + wc * 32 + 8 * fq;
        const int mode = (KIND == 0) ? 1 : (seg == 0 ? 2 : (seg >= 3 ? 3 : 0));
        f32x4 bv[2][2];
#pragma unroll
        for (int bj = 0; bj < 2; ++bj)
#pragma unroll
            for (int n = 0; n < 2; ++n) bv[bj][n] = (KIND == 1 && mode == 3) ? *(const f32x4*)(bias + (seg - 3) * 1024 + col0 + bj * HALF + 4 * n) : (f32x4){0.f, 0.f, 0.f, 0.f};
#pragma unroll
        for (int ai = 0; ai < 2; ++ai)
#pragma unroll
            for (int m = 0; m < 4; ++m) { bf16_t* rowp = dst + (size_t)(row0 + ai * HALF + m * 16) * 1024 + col0;
#pragma unroll
                for (int bj = 0; bj < 2; ++bj) { f32x4 v0 = acc[ai][bj][m][0], v1 = acc[ai][bj][m][1];
                    if (mode == 1) { f32x2 a = gelu_pk((f32x2){v0[0], v0[1]}), b = gelu_pk((f32x2){v0[2], v0[3]}), c = gelu_pk((f32x2){v1[0], v1[1]}), d = gelu_pk((f32x2){v1[2], v1[3]});
                        v0 = (f32x4){a.x, a.y, b.x, b.y}; v1 = (f32x4){c.x, c.y, d.x, d.y}; }
                    else if (mode == 2) { v0 = v0 * qscale; v1 = v1 * qscale; }
                    else if (mode == 3) { v0 = v0 + bv[bj][0]; v1 = v1 + bv[bj][1];
#pragma unroll
                        for (int e = 0; e < 1; ++e) { const f32x2 a = sigmoid_pk((f32x2){v0[0], v0[1]}), b = sigmoid_pk((f32x2){v0[2], v0[3]}), c = sigmoid_pk((f32x2){v1[0], v1[1]}), d = sigmoid_pk((f32x2){v1[2], v1[3]}); v0 = (f32x4){a.x, a.y, b.x, b.y}; v1 = (f32x4){c.x, c.y, d.x, d.y}; } }
                    u32x4 w; w.x = cvt_pk_bf16(v0[0], v0[1]); w.y = cvt_pk_bf16(v0[2], v0[3]); w.z = cvt_pk_bf16(v1[0], v1[1]); w.w = cvt_pk_bf16(v1[2], v1[3]);
                    *(u32x4*)(rowp + bj * HALF) = w; } }
    }
};
template <bool ADD> struct EpiGate {
    static constexpr bool PERM = true, AFTER_DRAIN = false;
    const bf16_t* gate; const bf16_t* add; bf16_t* dst;
    __device__ __forceinline__ void operator()(const f32x4 (&acc)[2][2][4][2], const Unit& u, int wr, int wc, int fr, int fq) const {
        const int row0 = u.pm * BM + wr * 64 + fr, col0 = u.pn * BM + wc * 32 + 8 * fq;
#pragma unroll
        for (int ai = 0; ai < 2; ++ai)
#pragma unroll
            for (int m = 0; m < 4; ++m) { const size_t off = (size_t)(row0 + ai * HALF + m * 16) * 1024 + col0;
#pragma unroll
                for (int bj = 0; bj < 2; ++bj) { const f32x4 v0 = acc[ai][bj][m][0], v1 = acc[ai][bj][m][1];
                    const u32x4 g = *(const u32x4*)(gate + off + bj * HALF);
                    float r[8] = { bf_lo(g.x) * v0[0], bf_hi(g.x) * v0[1], bf_lo(g.y) * v0[2], bf_hi(g.y) * v0[3], bf_lo(g.z) * v1[0], bf_hi(g.z) * v1[1], bf_lo(g.w) * v1[2], bf_hi(g.w) * v1[3] };
                    if (ADD) { const u32x4 a = *(const u32x4*)(add + off + bj * HALF);
                        r[0] += bf_lo(a.x); r[1] += bf_hi(a.x); r[2] += bf_lo(a.y); r[3] += bf_hi(a.y); r[4] += bf_lo(a.z); r[5] += bf_hi(a.z); r[6] += bf_lo(a.w); r[7] += bf_hi(a.w); }
                    u32x4 w; w.x = cvt_pk_bf16(r[0], r[1]); w.y = cvt_pk_bf16(r[2], r[3]); w.z = cvt_pk_bf16(r[4], r[5]); w.w = cvt_pk_bf16(r[6], r[7]);
                    *(u32x4*)(dst + off + bj * HALF) = w; } }
    }
};

template <class Epi, class Sched, bool ALIGN_EPI = false, bool SP2 = false, bool TILED_A = false>
__device__ __forceinline__ void gemm_phase(PG8_LAS unsigned char* lds, const Gemm g, const Sched& S, const Epi& E) {
    int tid_ = threadIdx.x; asm volatile("" : "+v"(tid_));
    const int tid = tid_, wid = __builtin_amdgcn_readfirstlane(tid >> 6), lane = tid & 63, wr = wid >> 2, wc = wid & 3, fr = lane & 15, fq = lane >> 4;
    const int K = g.K, nt = K / BK;
    unsigned voffA[2], voffB[2];
#pragma unroll
    for (int i = 0; i < 2; ++i) { int R, C; stage_rc(tid * 16 + i * 8192, R, C); const int Rb = Epi::PERM ? ((R & ~31) + perm32(R & 31)) : R;
        voffA[i] = (unsigned)(R * (TILED_A ? 256 : K) + C) * 2u; voffB[i] = (unsigned)(Rb * K + C) * 2u; }
    const size_t kstep = (size_t)(BK * 2);
    const size_t hstep = (size_t)HALF * K * 2;
    const size_t tstep = 2 * hstep;
    const size_t hstepA = TILED_A ? (size_t)HALF * 256 * 2 : hstep;
#define PG8_KOFS(t_) (TILED_A ? ((size_t)((t_) >> 2) * 131072 + (size_t)((t_) & 3) * 128) : (size_t)(t_) * kstep)
    const unsigned ldsw = (unsigned)wid * 1024u;
    const int aoff = lds_byte(wr * 64 + fr, fq * 8), boff = lds_byte(wc * 32 + fr, fq * 8);
#define PG8_SA(b, h) (((b) * 2 + (h)) * HTB)
#define PG8_SB(b, h) ((4 + (b) * 2 + (h)) * HTB)
#define PG8_STAGE(bufoff, gbase, voff) do { _Pragma("unroll") for (int _i = 0; _i < 2; ++_i) \
        __builtin_amdgcn_global_load_lds((const unsigned*)((const char*)(gbase) + (voff)[_i]), (PG8_LAS unsigned*)(lds + (bufoff) + ldsw + _i * 8192), 16, 0, 0); } while (0)
#define PG8_LDA(dst, b, h) do { _Pragma("unroll") for (int m = 0; m < 4; ++m) _Pragma("unroll") for (int k = 0; k < 2; ++k) dst[m][k] = *(const PG8_LAS bf16x8*)(lds + PG8_SA(b, h) + aoff + m * 2048 + k * 1024); } while (0)
#define PG8_LDB(dst, b, h) do { _Pragma("unroll") for (int n = 0; n < 2; ++n) _Pragma("unroll") for (int k = 0; k < 2; ++k) dst[n][k] = *(const PG8_LAS bf16x8*)(lds + PG8_SB(b, h) + boff + n * 2048 + k * 1024); } while (0)
#define PG8_MMA(ai, bj, At, Bt) do { __builtin_amdgcn_s_setprio(1); _Pragma("unroll") for (int m = 0; m < 4; ++m) _Pragma("unroll") for (int n = 0; n < 2; ++n) _Pragma("unroll") for (int k = 0; k < 2; ++k) \
        acc[ai][bj][m][n] = __builtin_amdgcn_mfma_f32_16x16x32_bf16(Bt[n][k], At[m][k], acc[ai][bj][m][n], 0, 0, 0); __builtin_amdgcn_s_setprio(0); } while (0)
#define PG8_WAIT_V(n) asm volatile("s_waitcnt vmcnt(" #n ")" ::: "memory")
#define PG8_WAIT_L(n) asm volatile("s_waitcnt lgkmcnt(" #n ")" ::: "memory")
#define PG8_BAR __builtin_amdgcn_s_barrier()
#define PG8_SCHED __builtin_amdgcn_sched_barrier(0)
    Unit cur, nxt; int ui = 0;
    if (!S.next(0, cur)) return;
    f32x4 acc[2][2][4][2];
#pragma unroll
    for (int a = 0; a < 2; ++a)
#pragma unroll
        for (int b = 0; b < 2; ++b)
#pragma unroll
            for (int m = 0; m < 4; ++m)
#pragma unroll
                for (int n = 0; n < 2; ++n) acc[a][b][m][n] = (f32x4){0.f, 0.f, 0.f, 0.f};
    bf16x8 At[4][2], B0[2][2], B1[2][2];
    const char* cA = (const char*)g.A + (size_t)cur.pm * tstep; const char* cB = (const char*)g.Bt + (size_t)cur.pn * tstep;
    S.a_ready(cur);
    if constexpr (SP2) {
        PG8_STAGE(PG8_SB(0, 0), cB, voffB); PG8_STAGE(PG8_SB(0, 1), cB + hstep, voffB); PG8_STAGE(PG8_SA(0, 0), cA, voffA); PG8_STAGE(PG8_SA(0, 1), cA + hstepA, voffA);
        if (wr == 1) PG8_BAR;
        PG8_WAIT_V(2); PG8_BAR;
        PG8_STAGE(PG8_SB(1, 0), cB + kstep, voffB); PG8_STAGE(PG8_SA(1, 0), cA + kstep, voffA); PG8_STAGE(PG8_SB(1, 1), cB + hstep + kstep, voffB);
        PG8_WAIT_V(6); PG8_BAR;
    } else {
        PG8_STAGE(PG8_SB(0, 0), cB, voffB); PG8_STAGE(PG8_SA(0, 0), cA, voffA); PG8_STAGE(PG8_SB(0, 1), cB + hstep, voffB); PG8_STAGE(PG8_SA(0, 1), cA + hstepA, voffA);
        if (wr == 1) PG8_BAR;
        PG8_WAIT_V(4); PG8_BAR;
        PG8_STAGE(PG8_SB(1, 0), cB + kstep, voffB); PG8_STAGE(PG8_SA(1, 0), cA + kstep, voffA); PG8_STAGE(PG8_SB(1, 1), cB + hstep + kstep, voffB);
        PG8_WAIT_V(6); PG8_BAR;
    }
    for (;;) {
        const bool has_next = S.next(ui + 1, nxt);
        const char* nA = has_next ? (const char*)g.A + (size_t)nxt.pm * tstep : cA; const char* nB = has_next ? (const char*)g.Bt + (size_t)nxt.pn * tstep : cB;
        for (int t = 0; t < nt; t += 2) {
            const bool last = (t == nt - 2);
            const char* a1 = cA + PG8_KOFS(t + 1);
            const char* a2 = last ? nA : cA + PG8_KOFS(t + 2); const char* b2 = last ? nB : cB + (size_t)(t + 2) * kstep;
            const char* a3 = a2 + kstep; const char* b3 = b2 + kstep;
            if (last && has_next) S.a_ready(nxt);
            if constexpr (SP2) {
            PG8_LDB(B0, 0, 0); PG8_LDB(B1, 0, 1); PG8_SCHED; PG8_LDA(At, 0, 0); PG8_STAGE(PG8_SA(1, 1), a1 + hstepA, voffA);
            PG8_WAIT_V(8); PG8_WAIT_L(0); PG8_BAR; PG8_MMA(0, 0, At, B0); PG8_MMA(0, 1, At, B1); PG8_BAR; PG8_SCHED;
            PG8_LDA(At, 0, 1); PG8_STAGE(PG8_SB(0, 0), b2, voffB); PG8_STAGE(PG8_SB(0, 1), b2 + hstep, voffB); PG8_STAGE(PG8_SA(0, 0), a2, voffA);
            PG8_WAIT_V(8); PG8_WAIT_L(0); PG8_BAR; PG8_MMA(1, 0, At, B0); PG8_MMA(1, 1, At, B1); PG8_BAR; PG8_SCHED;
            PG8_LDB(B0, 1, 0); PG8_LDB(B1, 1, 1); PG8_SCHED; PG8_LDA(At, 1, 0); PG8_STAGE(PG8_SA(0, 1), a2 + hstepA, voffA);
            PG8_WAIT_V(8); PG8_WAIT_L(0); PG8_BAR; PG8_MMA(0, 0, At, B0); PG8_MMA(0, 1, At, B1); PG8_BAR; PG8_SCHED;
            PG8_LDA(At, 1, 1); PG8_STAGE(PG8_SB(1, 0), b3, voffB); PG8_STAGE(PG8_SB(1, 1), b3 + hstep, voffB); PG8_STAGE(PG8_SA(1, 0), a3, voffA);
            PG8_WAIT_V(8); PG8_WAIT_L(0); PG8_BAR; PG8_MMA(1, 0, At, B0); PG8_MMA(1, 1, At, B1); PG8_BAR; PG8_SCHED;
            } else {
            PG8_LDB(B0, 0, 0); PG8_SCHED; PG8_LDA(At, 0, 0); PG8_STAGE(PG8_SA(1, 1), a1 + hstepA, voffA);
            PG8_WAIT_L(8); PG8_BAR; PG8_WAIT_L(0); PG8_MMA(0, 0, At, B0); PG8_BAR; PG8_SCHED;
            PG8_LDB(B1, 0, 1); PG8_STAGE(PG8_SB(0, 0), b2, voffB);
            PG8_BAR; PG8_WAIT_L(0); PG8_MMA(0, 1, At, B1); PG8_BAR;
            PG8_LDA(At, 0, 1); PG8_STAGE(PG8_SA(0, 0), a2, voffA);
            PG8_BAR; PG8_WAIT_L(0); PG8_MMA(1, 0, At, B0); PG8_BAR; PG8_SCHED;
            PG8_STAGE(PG8_SB(0, 1), b2 + hstep, voffB);
            PG8_WAIT_V(6); PG8_BAR; PG8_MMA(1, 1, At, B1); PG8_BAR;
            PG8_LDB(B0, 1, 0); PG8_SCHED; PG8_LDA(At, 1, 0); PG8_STAGE(PG8_SA(0, 1), a2 + hstepA, voffA);
            PG8_WAIT_L(8); PG8_BAR; PG8_WAIT_L(0); PG8_MMA(0, 0, At, B0); PG8_BAR; PG8_SCHED;
            PG8_LDB(B1, 1, 1); PG8_STAGE(PG8_SB(1, 0), b3, voffB);
            PG8_BAR; PG8_WAIT_L(0); PG8_MMA(0, 1, At, B1); PG8_BAR;
            PG8_LDA(At, 1, 1); PG8_STAGE(PG8_SA(1, 0), a3, voffA);
            PG8_BAR; PG8_WAIT_L(0); PG8_MMA(1, 0, At, B0); PG8_BAR; PG8_SCHED;
            PG8_STAGE(PG8_SB(1, 1), b3 + hstep, voffB);
            PG8_WAIT_V(6); PG8_BAR; PG8_MMA(1, 1, At, B1); PG8_BAR;
            }
        }
        if constexpr (ALIGN_EPI) { if (wr == 0) PG8_BAR; }
        if constexpr (!Epi::AFTER_DRAIN) { E(acc, cur, wr, wc, fr, fq); S.done(cur); }
        if (!has_next) break;
#pragma unroll
        for (int a = 0; a < 2; ++a)
#pragma unroll
            for (int b = 0; b < 2; ++b)
#pragma unroll
                for (int m = 0; m < 4; ++m)
#pragma unroll
                    for (int n = 0; n < 2; ++n) acc[a][b][m][n] = (f32x4){0.f, 0.f, 0.f, 0.f};
        cur = nxt; cA = nA; cB = nB; ++ui;
        if constexpr (ALIGN_EPI) { if (wr == 1) PG8_BAR; }
    }
    PG8_WAIT_V(0);
    if constexpr (!ALIGN_EPI) { if (wr == 0) PG8_BAR; }
    PG8_BAR;
    if constexpr (Epi::AFTER_DRAIN) { E.fused(acc, cur, wr, wc, fr, fq, lds, wid, lane); S.done(cur); }
#undef PG8_SA
#undef PG8_SB
#undef PG8_STAGE
#undef PG8_LDA
#undef PG8_LDB
#undef PG8_MMA
#undef PG8_WAIT_V
#undef PG8_WAIT_L
#undef PG8_BAR
#undef PG8_SCHED
#undef PG8_KOFS
}
}
#define GAS __attribute__((address_space(1)))
#define LAS __attribute__((address_space(3)))
typedef unsigned short bf16;
typedef unsigned v4u __attribute__((ext_vector_type(4)));
typedef unsigned v2u __attribute__((ext_vector_type(2)));
typedef float f32x4 __attribute__((ext_vector_type(4)));
typedef float f32x16 __attribute__((ext_vector_type(16)));
typedef short bf16x8 __attribute__((ext_vector_type(8)));
typedef short s16x4 __attribute__((ext_vector_type(4)));

constexpr int NWAVES = 8, NTHREADS = 512;
constexpr int BATCH = 32, SEQ = 2048, D = 1024, FF = 2816, M = BATCH * SEQ;
constexpr int NGU = 2 * FF;
constexpr int DIN = 7168;
constexpr float EPS = 1e-6f;
constexpr size_t MiB = 1u << 20;
constexpr size_t WS_WGU1 = 2 * MiB, WS_WD1 = 13 * MiB, WS_WIN = 19 * MiB, WS_WA = 33 * MiB, WS_WB = 35 * MiB, WS_WOUT = 37 * MiB, WS_WGU2 = 39 * MiB, WS_WD2 = 50 * MiB;
constexpr size_t WS_XN = 64 * MiB;
constexpr size_t WS_U = 192 * MiB;
constexpr size_t WS_VG = 320 * MiB;
constexpr size_t WS_Q = 448 * MiB;
constexpr size_t WS_K = 576 * MiB, WS_V = 704 * MiB;
constexpr size_t WS_GB = 832 * MiB;
constexpr size_t WS_H = 192 * MiB;
constexpr size_t WS_XBUF = 960 * MiB;
constexpr size_t WS_CNT = 1 * MiB;
constexpr size_t WS_END = 962 * MiB;
constexpr int LDS_BYTES = 147456;
constexpr float QSCALE = 0.125f * 1.4426950408889634f;

__device__ __forceinline__ unsigned f2bf(float f) { unsigned u = __builtin_bit_cast(unsigned, f); return (u + 0x7fffu + ((u >> 16) & 1u)) >> 16; }
__device__ __forceinline__ unsigned pk2(float lo, float hi) { return f2bf(lo) | (f2bf(hi) << 16); }
__device__ __forceinline__ float bflo(unsigned w) { return __uint_as_float(w << 16); }
__device__ __forceinline__ float bfhi(unsigned w) { return __uint_as_float(w & 0xffff0000u); }
__device__ __forceinline__ float wave_sum(float v) {
#pragma unroll
    for (int o = 1; o < 64; o <<= 1) v += __shfl_xor(v, o);
    return v;
}
#define LDS_WAIT() asm volatile("s_waitcnt lgkmcnt(0)" ::: "memory")

__device__ __forceinline__ void p0_transpose_item(const float* W, int K, int N, bf16* WT, int mode, const float* gain, LAS float* scr, int item, int lane) {
    const int nblk = N / 32, kb = item / nblk, nb = item % nblk, k0 = 64 * kb, n0 = 32 * nb;
    const int row0 = (mode == 0) ? n0 : (256 * (n0 >> 7) + (n0 & 127) + (mode == 2 ? 128 : 0));
#pragma unroll 8
    for (int i = 0; i < 32; ++i) { const int kk = 2 * i + (lane >> 5); scr[kk * 33 + (lane & 31)] = W[(size_t)(k0 + kk) * N + n0 + (lane & 31)] * (gain ? gain[k0 + kk] : 1.0f); }
    LDS_WAIT(); asm volatile("" ::: "memory");
    const int c = lane & 7;
#pragma unroll
    for (int j = 0; j < 4; ++j) { const int n = (lane >> 3) + 8 * j; const LAS float* s = scr + (8 * c) * 33 + n;
        v4u o; o.x = pk2(s[0 * 33], s[1 * 33]); o.y = pk2(s[2 * 33], s[3 * 33]); o.z = pk2(s[4 * 33], s[5 * 33]); o.w = pk2(s[6 * 33], s[7 * 33]);
        *(GAS v4u*)(WT + (size_t)(row0 + n) * K + k0 + 8 * c) = o; }
    LDS_WAIT(); asm volatile("" ::: "memory");
}
template <bool TO_F32> __device__ __forceinline__ void rms_rows(const float* X, const float* gain, void* out, float* rstd_out, int gw, int NGW, int lane) {
    f32x4 g[4];
#pragma unroll
    for (int j = 0; j < 4; ++j) g[j] = gain ? *((const f32x4*)gain + lane + 64 * j) : (f32x4){1.f, 1.f, 1.f, 1.f};
    for (int m = gw; m < M; m += 2 * NGW) {
        const int m2 = m + NGW;
        const bool two = m2 < M;
        const GAS f32x4* xr = (const GAS f32x4*)(X + (size_t)m * D) + lane;
        const GAS f32x4* xs = (const GAS f32x4*)(X + (size_t)(two ? m2 : m) * D) + lane;
        f32x4 v[4], w[4]; float s = 0.f, t = 0.f;
#pragma unroll
        for (int j = 0; j < 4; ++j) { v[j] = xr[64 * j]; w[j] = xs[64 * j]; }
#pragma unroll
        for (int j = 0; j < 4; ++j) { s += (v[j].x * v[j].x + v[j].y * v[j].y) + (v[j].z * v[j].z + v[j].w * v[j].w); t += (w[j].x * w[j].x + w[j].y * w[j].y) + (w[j].z * w[j].z + w[j].w * w[j].w); }
        const float rs = 1.0f / sqrtf(wave_sum(s) * (1.f / D) + EPS), rt = 1.0f / sqrtf(wave_sum(t) * (1.f / D) + EPS);
        if (rstd_out && lane == 0) { rstd_out[m] = rs; if (two) rstd_out[m2] = rt; }
        if (TO_F32) { GAS f32x4* o = (GAS f32x4*)((float*)out + (size_t)m * D) + lane; GAS f32x4* o2 = (GAS f32x4*)((float*)out + (size_t)m2 * D) + lane;
#pragma unroll
            for (int j = 0; j < 4; ++j) { o[64 * j] = v[j] * rs * g[j]; if (two) o2[64 * j] = w[j] * rt * g[j]; } }
        else { GAS v2u* o = (GAS v2u*)((bf16*)out + ((size_t)(m >> 8) << 18) + (size_t)(m & 255) * 256) + lane; GAS v2u* o2 = (GAS v2u*)((bf16*)out + ((size_t)(m2 >> 8) << 18) + (size_t)(m2 & 255) * 256) + lane;
#pragma unroll
            for (int j = 0; j < 4; ++j) { const f32x4 y = v[j] * rs * g[j], z = w[j] * rt * g[j]; v2u a, b; a.x = pk2(y.x, y.y); a.y = pk2(y.z, y.w); b.x = pk2(z.x, z.y); b.y = pk2(z.z, z.w); o[16384 * j] = a; if (two) o2[16384 * j] = b; } }
    }
}

namespace gm {
constexpr int VP = 576;
constexpr int SP = 528;
constexpr int OFF_V = 0, OFF_S = 128 * VP;
static_assert(OFF_S + 128 * SP <= 147456, "gmlp LDS");
__device__ __forceinline__ int crow(int r, int hi) { return (r & 3) + 8 * (r >> 2) + 4 * hi; }
template <bool DRY> __device__ __forceinline__ void phase(LAS unsigned char* lds, bf16* U, const bf16* VG, const float* ln_g, const float* ln_b, const float* w_s, const float* b_s, int vcu, int G) {
    const int tid = threadIdx.x, lane = tid & 63, wid = __builtin_amdgcn_readfirstlane(tid >> 6), r32 = lane & 31, hi = lane >> 5;
    const int g = vcu & 3, tslab = wid & 3, chalf = wid >> 2, t0 = 32 * tslab;
    const int nks = (tslab < 2) ? 4 : 8;
    bf16x8 wa[8];
#pragma unroll
    for (int ks = 0; ks < 8; ++ks) { const float* wp = w_s + ((size_t)(g * 128 + t0 + r32)) * 128 + 16 * ks + 8 * hi; const f32x4 a = *(const f32x4*)wp, b = *(const f32x4*)(wp + 4);
        v4u w; w.x = pk2(a.x, a.y); w.y = pk2(a.z, a.w); w.z = pk2(b.x, b.y); w.w = pk2(b.z, b.w); wa[ks] = __builtin_bit_cast(bf16x8, w); }
    float bs[16];
#pragma unroll
    for (int r = 0; r < 16; ++r) bs[r] = b_s[g * 128 + t0 + crow(r, hi)];
    const int lrow = lane >> 4, c0 = 16 * (lane & 15);
    f32x4 lg[4], lb[4];
#pragma unroll
    for (int j = 0; j < 4; ++j) { lg[j] = *(const f32x4*)(ln_g + g * 256 + c0 + 4 * j); lb[j] = *(const f32x4*)(ln_b + g * 256 + c0 + 4 * j); }
    const unsigned tra = (unsigned)(8 * hi + ((lane & 15) >> 2)) * VP + (unsigned)(16 * ((lane >> 4) & 1) + 4 * (lane & 3)) * 2;
    v4u va[4], vb[4];
    { const size_t R0 = (size_t)(vcu >> 2) * 128;
#pragma unroll
      for (int it = 0; it < 4; ++it) { const bf16* vp = VG + (R0 + 16 * wid + 4 * it + lrow) * 1024 + g * 256 + c0; va[it] = *(const GAS v4u*)vp; vb[it] = *(const GAS v4u*)(vp + 8); } }
    for (int blk = (vcu >> 2); blk < M / 128; blk += (G >> 2)) {
        const size_t R0 = (size_t)blk * 128;
#pragma unroll
        for (int it = 0; it < 4; ++it) {
            const int row = 16 * wid + 4 * it + lrow;
            const v4u a = va[it], b = vb[it];
            float x[16] = { bflo(a.x), bfhi(a.x), bflo(a.y), bfhi(a.y), bflo(a.z), bfhi(a.z), bflo(a.w), bfhi(a.w), bflo(b.x), bfhi(b.x), bflo(b.y), bfhi(b.y), bflo(b.z), bfhi(b.z), bflo(b.w), bfhi(b.w) };
            float s = 0.f;
#pragma unroll
            for (int e = 0; e < 16; ++e) s += x[e];
            s += __shfl_xor(s, 1); s += __shfl_xor(s, 2); s += __shfl_xor(s, 4); s += __shfl_xor(s, 8);
            const float mean = s * (1.f / 256.f); float q = 0.f;
#pragma unroll
            for (int e = 0; e < 16; ++e) { x[e] -= mean; q += x[e] * x[e]; }
            q += __shfl_xor(q, 1); q += __shfl_xor(q, 2); q += __shfl_xor(q, 4); q += __shfl_xor(q, 8);
            const float rstd = 1.0f / sqrtf(q * (1.f / 256.f) + EPS);
            float y[16];
#pragma unroll
            for (int j = 0; j < 4; ++j)
#pragma unroll
                for (int e = 0; e < 4; ++e) y[4 * j + e] = x[4 * j + e] * rstd * lg[j][e] + lb[j][e];
            v4u o0, o1; o0.x = pk2(y[0], y[1]); o0.y = pk2(y[2], y[3]); o0.z = pk2(y[4], y[5]); o0.w = pk2(y[6], y[7]); o1.x = pk2(y[8], y[9]); o1.y = pk2(y[10], y[11]); o1.z = pk2(y[12], y[13]); o1.w = pk2(y[14], y[15]);
            LAS unsigned char* dp = lds + OFF_V + row * VP + c0 * 2;
            *(LAS v4u*)dp = o0; *(LAS v4u*)(dp + 16) = o1;
        }
        __syncthreads();
        v4u ur[8];
#pragma unroll
        for (int it = 0; it < 8; ++it) { const int id = tid + 512 * it, row = id >> 5, ch = id & 31; ur[it] = *(const GAS v4u*)(U + (R0 + row) * 1024 + g * 256 + ch * 8); }
        { const int nb = blk + (G >> 2); const size_t Rn = (size_t)(nb < M / 128 ? nb : blk) * 128;
#pragma unroll
          for (int it = 0; it < 4; ++it) { const bf16* vp = VG + (Rn + 16 * wid + 4 * it + lrow) * 1024 + g * 256 + c0; va[it] = *(const GAS v4u*)vp; vb[it] = *(const GAS v4u*)(vp + 8); } }
#pragma unroll 1
        for (int cb = 0; cb < 4; ++cb) {
            const int cblk = chalf * 4 + cb;
            f32x16 acc = {0.f, 0.f, 0.f, 0.f, 0.f, 0.f, 0.f, 0.f, 0.f, 0.f, 0.f, 0.f, 0.f, 0.f, 0.f, 0.f};
            const LAS unsigned char* bp = lds + OFF_V + tra + cblk * 64;
#pragma unroll
            for (int ks = 0; ks < 8; ++ks) {
                if (ks < nks) {
                    const s16x4 lo = __builtin_bit_cast(s16x4, __builtin_amdgcn_ds_read_tr16_b64_v4i16((LAS s16x4*)(bp + ks * 16 * VP)));
                    const s16x4 h4 = __builtin_bit_cast(s16x4, __builtin_amdgcn_ds_read_tr16_b64_v4i16((LAS s16x4*)(bp + ks * 16 * VP + 4 * VP)));
                    const bf16x8 bfr = (bf16x8){lo[0], lo[1], lo[2], lo[3], h4[0], h4[1], h4[2], h4[3]};
                    acc = __builtin_amdgcn_mfma_f32_32x32x16_bf16(wa[ks], bfr, acc, 0, 0, 0);
                }
            }
#pragma unroll
            for (int r = 0; r < 16; ++r) *(LAS unsigned short*)(lds + OFF_S + (t0 + crow(r, hi)) * SP + (32 * cblk + r32) * 2) = (unsigned short)f2bf(acc[r] + bs[r]);
        }
        __syncthreads();
#pragma unroll
        for (int it = 0; it < 8; ++it) {
            const int id = tid + 512 * it, row = id >> 5, ch = id & 31;
            const v4u sm = *(const LAS v4u*)(lds + OFF_S + row * SP + ch * 16);
            bf16* up = U + (R0 + row) * 1024 + g * 256 + ch * 8;
            const v4u uu = ur[it];
            v4u o; o.x = pk2(bflo(uu.x) * bflo(sm.x), bfhi(uu.x) * bfhi(sm.x)); o.y = pk2(bflo(uu.y) * bflo(sm.y), bfhi(uu.y) * bfhi(sm.y));
            o.z = pk2(bflo(uu.z) * bflo(sm.z), bfhi(uu.z) * bfhi(sm.z)); o.w = pk2(bflo(uu.w) * bflo(sm.w), bfhi(uu.w) * bfhi(sm.w));
            if (!DRY || o.x == 0x12345678u) *(GAS v4u*)up = o;
        }
    }
    __syncthreads();
}
}

namespace sb {
constexpr int KP = 1040;
constexpr int VP = 192;
constexpr int KBYTES = 8448, VBYTES = 64 * VP;
constexpr int OFF_K = 0, OFF_V = 2 * KBYTES, OFF_F = OFF_V + 2 * VBYTES;
constexpr float R_STOP = 3.552713678800501e-15f;
__device__ __forceinline__ int crow(int r, int hi) { return (r & 3) + 8 * (r >> 2) + 4 * hi; }

template <bool MASKED> __device__ __forceinline__ float scan(f32x16& p0, f32x16& p1, int jlim) {
    float run = 1.f;
#pragma unroll
    for (int j = 31; j >= 0; --j) {
        const float z = (j < 16) ? p0[j & 15] : p1[j & 15];
        float r = __builtin_amdgcn_rcpf(1.0f + __builtin_amdgcn_exp2f(z));
        if (MASKED) r = (j < jlim) ? r : 1.0f;
        const float t = r * run, w = run - t;
        if (j < 16) p0[j & 15] = w; else p1[j & 15] = w;
        run = t;
    }
    return run;
}

typedef float f32x2s __attribute__((ext_vector_type(2)));
template <bool MASKED> __device__ __forceinline__ void scan2(f32x16& p0, f32x16& p1, int jlim, int hi, float& R) {
    float r[32];
#pragma unroll
    for (int j = 0; j < 32; ++j) { float e = __builtin_amdgcn_exp2f((j < 16) ? p0[j & 15] : p1[j & 15]); if (MASKED) e = (j < jlim) ? e : 0.f; if (j < 16) p0[j & 15] = e; else p1[j & 15] = e; }
#pragma unroll
    for (int j = 0; j < 32; j += 2) {
        const f32x2s e = (j < 16) ? (f32x2s){p0[j & 15], p0[(j & 15) + 1]} : (f32x2s){p1[j & 15], p1[(j & 15) + 1]};
        const f32x2s d = e + 1.0f;
        r[j] = __builtin_amdgcn_rcpf(d.x); r[j + 1] = __builtin_amdgcn_rcpf(d.y);
        const f32x2s bt = 1.0f - (f32x2s){r[j], r[j + 1]};
        if (j < 16) { p0[j & 15] = bt.x; p0[(j & 15) + 1] = bt.y; } else { p1[j & 15] = bt.x; p1[(j & 15) + 1] = bt.y; }
    }
    f32x2s t8[8];
#pragma unroll
    for (int i = 0; i < 8; ++i) t8[i] = (f32x2s){r[4 * i], r[4 * i + 1]} * (f32x2s){r[4 * i + 2], r[4 * i + 3]};
#pragma unroll
    for (int i = 0; i < 4; ++i) t8[i] = t8[2 * i] * t8[2 * i + 1];
    t8[0] = t8[0] * t8[1]; t8[2] = t8[2] * t8[3];
    const f32x2s tt = t8[0] * t8[2];
    const float T = tt.x * tt.y;
    const float Tp = __shfl_xor(T, 32);
    float run = hi ? R : R * Tp;
    R = R * T * Tp;
#pragma unroll
    for (int j = 31; j >= 0; --j) { const float nx = run * r[j]; r[j] = run; run = nx; }
#pragma unroll
    for (int j = 0; j < 32; j += 2) {
        const f32x2s bt = (j < 16) ? (f32x2s){p0[j & 15], p0[(j & 15) + 1]} : (f32x2s){p1[j & 15], p1[(j & 15) + 1]};
        const f32x2s w = bt * (f32x2s){r[j], r[j + 1]};
        if (j < 16) { p0[j & 15] = w.x; p0[(j & 15) + 1] = w.y; } else { p1[j & 15] = w.x; p1[(j & 15) + 1] = w.y; }
    }
}

struct Pre { bf16x8 qr[4]; v4u kreg, vreg, k1, v1; };
__device__ __forceinline__ void preload(Pre& P, int u, const bf16* Q, const bf16* K, const bf16* V) {
    const int tid = threadIdx.x, lane = tid & 63, wid = __builtin_amdgcn_readfirstlane(tid >> 6), r32 = lane & 31, hi = lane >> 5;
    const int bh = u >> 3, qb = u & 7, b = bh >> 4, h = bh & 15;
    const size_t rb = (size_t)b * SEQ; const int qw0 = qb * 256 + 32 * wid, kt = 4 * qb + 3;
    const bf16* Qw = Q + (rb + qw0 + r32) * 1024 + h * 64 + hi * 8;
#pragma unroll
    for (int d0 = 0; d0 < 4; ++d0) P.qr[d0] = *(const GAS bf16x8*)(Qw + d0 * 16);
    const int skey = tid >> 3, sch = tid & 7;
    const bf16* Kg = K + (rb + skey) * 1024 + h * 64 + sch * 8; const bf16* Vg = V + (rb + skey) * 1024 + h * 64 + sch * 8;
    P.kreg = *(const GAS v4u*)(Kg + (size_t)kt * 64 * 1024); P.vreg = *(const GAS v4u*)(Vg + (size_t)kt * 64 * 1024);
    P.k1 = *(const GAS v4u*)(Kg + (size_t)(kt - 1) * 64 * 1024); P.v1 = *(const GAS v4u*)(Vg + (size_t)(kt - 1) * 64 * 1024);
}
template <bool DRY> __device__ __forceinline__ void unit(LAS unsigned char* lds, int b, int h, int qb, bf16* Q, const bf16* K, const bf16* V, Pre& P, int unext) {
    const int tid = threadIdx.x, lane = tid & 63, wid = __builtin_amdgcn_readfirstlane(tid >> 6), r32 = lane & 31, hi = lane >> 5;
    const size_t rb = (size_t)b * SEQ;
    const int q0 = qb * 256, qw0 = q0 + 32 * wid, myq = qw0 + r32;
    const int ktd = 4 * qb + (wid >> 1);
    bf16x8 qr[4];
#pragma unroll
    for (int d0 = 0; d0 < 4; ++d0) qr[d0] = P.qr[d0];
    const int skey = tid >> 3, sch = tid & 7;
    const bf16* Kg = K + (rb + skey) * 1024 + h * 64 + sch * 8;
    const bf16* Vg = V + (rb + skey) * 1024 + h * 64 + sch * 8;
    const unsigned ksw = (unsigned)(sch * KP + skey * 16), vsw = (unsigned)(skey * VP + sch * 16);
    const int pk = 32 * ((r32 >> 2) & 1) + (r32 & 3) + 4 * (r32 >> 3);
    const unsigned kra = (unsigned)(hi * KP + pk * 16);
    const unsigned vra = (unsigned)((32 * hi + ((lane & 15) >> 2)) * VP + (16 * ((lane >> 4) & 1) + 4 * (lane & 3)) * 2);
    volatile LAS unsigned* flags = (volatile LAS unsigned*)(lds + OFF_F);
    f32x16 o0 = {0.f, 0.f, 0.f, 0.f, 0.f, 0.f, 0.f, 0.f, 0.f, 0.f, 0.f, 0.f, 0.f, 0.f, 0.f, 0.f}, o1 = o0;
    float R = 1.f; bool alive = true;
    int kt = 4 * qb + 3, buf = 0;
    const v4u kreg = P.kreg, vreg = P.vreg; v4u k1 = P.k1, v1 = P.v1;
    *(LAS v4u*)(lds + OFF_K + ksw) = kreg; *(LAS v4u*)(lds + OFF_V + vsw) = vreg;
    asm volatile("s_waitcnt lgkmcnt(0)" ::: "memory"); __builtin_amdgcn_s_barrier(); asm volatile("" ::: "memory");
    if (unext >= 0) preload(P, unext, Q, K, V);
    for (;;) {
        const bool has_next = kt > 0;
        const int kt2 = kt > 1 ? kt - 2 : 0;
        const v4u k2 = *(const GAS v4u*)(Kg + (size_t)kt2 * 64 * 1024), v2 = *(const GAS v4u*)(Vg + (size_t)kt2 * 64 * 1024);
        if (kt <= ktd && alive) {
            const LAS unsigned char* Kb = lds + OFF_K + buf * KBYTES + kra;
            const LAS unsigned char* Vb = lds + OFF_V + buf * VBYTES + vra;
            f32x16 p0 = {0.f, 0.f, 0.f, 0.f, 0.f, 0.f, 0.f, 0.f, 0.f, 0.f, 0.f, 0.f, 0.f, 0.f, 0.f, 0.f}, p1 = p0;
#pragma unroll
            for (int d0 = 0; d0 < 4; ++d0) {
                const bf16x8 ka = *(const LAS bf16x8*)(Kb + d0 * 2 * KP), kb = *(const LAS bf16x8*)(Kb + d0 * 2 * KP + 256);
                p0 = __builtin_amdgcn_mfma_f32_32x32x16_bf16(ka, qr[d0], p0, 0, 0, 0);
                p1 = __builtin_amdgcn_mfma_f32_32x32x16_bf16(kb, qr[d0], p1, 0, 0, 0);
            }
            if (kt == ktd) scan2<true>(p0, p1, myq - (64 * kt + 32 * hi), hi, R); else scan2<false>(p0, p1, 64, hi, R);
            bf16x8 pa[4];
            { v4u w;
              w.x = pg8::cvt_pk_bf16(p0[0], p0[1]); w.y = pg8::cvt_pk_bf16(p0[2], p0[3]); w.z = pg8::cvt_pk_bf16(p0[4], p0[5]); w.w = pg8::cvt_pk_bf16(p0[6], p0[7]); pa[0] = __builtin_bit_cast(bf16x8, w);
              w.x = pg8::cvt_pk_bf16(p0[8], p0[9]); w.y = pg8::cvt_pk_bf16(p0[10], p0[11]); w.z = pg8::cvt_pk_bf16(p0[12], p0[13]); w.w = pg8::cvt_pk_bf16(p0[14], p0[15]); pa[1] = __builtin_bit_cast(bf16x8, w);
              w.x = pg8::cvt_pk_bf16(p1[0], p1[1]); w.y = pg8::cvt_pk_bf16(p1[2], p1[3]); w.z = pg8::cvt_pk_bf16(p1[4], p1[5]); w.w = pg8::cvt_pk_bf16(p1[6], p1[7]); pa[2] = __builtin_bit_cast(bf16x8, w);
              w.x = pg8::cvt_pk_bf16(p1[8], p1[9]); w.y = pg8::cvt_pk_bf16(p1[10], p1[11]); w.z = pg8::cvt_pk_bf16(p1[12], p1[13]); w.w = pg8::cvt_pk_bf16(p1[14], p1[15]); pa[3] = __builtin_bit_cast(bf16x8, w); }
#pragma unroll
            for (int j = 0; j < 4; ++j) {
                const s16x4 a0 = __builtin_bit_cast(s16x4, __builtin_amdgcn_ds_read_tr16_b64_v4i16((LAS s16x4*)(Vb + j * 8 * VP)));
                const s16x4 a1 = __builtin_bit_cast(s16x4, __builtin_amdgcn_ds_read_tr16_b64_v4i16((LAS s16x4*)(Vb + j * 8 * VP + 4 * VP)));
                const s16x4 b0 = __builtin_bit_cast(s16x4, __builtin_amdgcn_ds_read_tr16_b64_v4i16((LAS s16x4*)(Vb + j * 8 * VP + 64)));
                const s16x4 b1 = __builtin_bit_cast(s16x4, __builtin_amdgcn_ds_read_tr16_b64_v4i16((LAS s16x4*)(Vb + j * 8 * VP + 4 * VP + 64)));
                o0 = __builtin_amdgcn_mfma_f32_32x32x16_bf16(pa[j], (bf16x8){a0[0], a0[1], a0[2], a0[3], a1[0], a1[1], a1[2], a1[3]}, o0, 0, 0, 0);
                o1 = __builtin_amdgcn_mfma_f32_32x32x16_bf16(pa[j], (bf16x8){b0[0], b0[1], b0[2], b0[3], b1[0], b1[1], b1[2], b1[3]}, o1, 0, 0, 0);
            }
            alive = __any(R > R_STOP);
        }
        if (has_next) { *(LAS v4u*)(lds + OFF_K + (buf ^ 1) * KBYTES + ksw) = k1; *(LAS v4u*)(lds + OFF_V + (buf ^ 1) * VBYTES + vsw) = v1; }
        k1 = k2; v1 = v2;
        if (lane == 0) flags[buf * 8 + wid] = alive ? 1u : 0u;
        asm volatile("s_waitcnt lgkmcnt(0)" ::: "memory"); __builtin_amdgcn_s_barrier(); asm volatile("" ::: "memory");
        if (!has_next) break;
        unsigned any = 0u;
#pragma unroll
        for (int w = 0; w < 8; ++w) any |= flags[buf * 8 + w];
        if (!any) break;
        --kt; buf ^= 1;
    }
    { LAS unsigned short* stg = (LAS unsigned short*)(lds + 65536 + wid * 4096);
#pragma unroll
      for (int r = 0; r < 16; ++r) { const int orow = crow(r, hi); stg[orow * 64 + r32] = (unsigned short)f2bf(o0[r]); stg[orow * 64 + 32 + r32] = (unsigned short)f2bf(o1[r]); }
      asm volatile("s_waitcnt lgkmcnt(0)" ::: "memory");
      bf16* Ob = Q + (rb + qw0) * 1024 + h * 64;
#pragma unroll
      for (int i = 0; i < 4; ++i) { const int row = i * 8 + (lane >> 3), ch = lane & 7; const v4u v = *(const LAS v4u*)((LAS unsigned char*)stg + row * 128 + ch * 16); if (!DRY || v.x == 0x12345678u) *(GAS v4u*)(Ob + (size_t)row * 1024 + ch * 8) = v; }
      asm volatile("s_waitcnt lgkmcnt(0)" ::: "memory"); }
}
template <bool DRY> __device__ __forceinline__ void phase(LAS unsigned char* lds, bf16* Q, const bf16* K, const bf16* V, int vcu, int G) {
    constexpr int NU = BATCH * 16 * 8;
    Pre P; if (vcu < NU) preload(P, vcu, Q, K, V);
    for (int u = vcu; u < NU; u += G) { const int bh = u >> 3, qb = u & 7; unit<DRY>(lds, bh >> 4, bh & 15, qb, Q, K, V, P, (u + G < NU) ? u + G : -1); }
    __syncthreads();
}
}

typedef GAS unsigned gu32;
#define XB_TMO      128
#define XB_XCNT(j)  (256  + 64 * (j))
#define XB_XSUB(j)  (1280 + 64 * (j))
#define XB_XGEN(j)  (2304 + 64 * (j))
#define XB_TOP      3328
#define XB_TOPGEN   3392
#define XCD_BAR_WORDS 3456
#define XB_SPIN_CAP (1u << 18)

__device__ __forceinline__ unsigned xb_ld(unsigned* p)              { return __hip_atomic_load(p, __ATOMIC_RELAXED, __HIP_MEMORY_SCOPE_AGENT); }
__device__ __forceinline__ unsigned xb_add(unsigned* p, unsigned v) { return __hip_atomic_fetch_add(p, v, __ATOMIC_RELAXED, __HIP_MEMORY_SCOPE_AGENT); }
__device__ __forceinline__ unsigned xb_xcc_id() { return (unsigned)__builtin_amdgcn_s_getreg((3 << 11) | 20) & 0xFu; }
#define XB_SPIN(cond, bar) do { unsigned _sp = 0; while (cond) { __builtin_amdgcn_s_sleep(1); \
    if ((++_sp & 255u) == 0u) { if (xb_ld(&(bar)[XB_TMO])) break; if (_sp > XB_SPIN_CAP) { atomicAdd(&(bar)[XB_TMO], 1u); break; } } } } while (0)

struct XcdBarrier {
    unsigned* bar; unsigned x;
    volatile LAS unsigned* st;
};

__device__ __forceinline__ XcdBarrier xcd_barrier_post(unsigned* bar, volatile LAS unsigned* st) {
    XcdBarrier b; b.bar = bar; b.x = xb_xcc_id(); b.st = st;
    if (threadIdx.x == 0) (void)xb_add(&bar[XB_XCNT(b.x)], 1u);
    return b;
}
__device__ __forceinline__ void xcd_barrier_complete(unsigned* bar, unsigned x, unsigned& nloc, unsigned& nx) {
    const unsigned G = gridDim.x * gridDim.y * gridDim.z;
    unsigned sum, cnt, mine, sp = 0u;
    for (;;) {
        sum = 0u; cnt = 0u; mine = 0u;
#pragma unroll
        for (unsigned j = 0; j < 16; ++j) { const unsigned c = xb_ld(&bar[XB_XCNT(j)]); sum += c; cnt += (c > 0u) ? 1u : 0u; mine = (j == x) ? c : mine; }
        if (sum == G) break;
        __builtin_amdgcn_s_sleep(1);
        if ((++sp & 255u) == 0u) { if (xb_ld(&bar[XB_TMO])) break; if (sp > XB_SPIN_CAP) { atomicAdd(&bar[XB_TMO], 1u); break; } }
    }
    nloc = mine > 0u ? mine : 1u; nx = cnt > 0u ? cnt : 1u;
}

__device__ __forceinline__ void xcd_barrier(const XcdBarrier& b) {
    asm volatile("s_waitcnt vmcnt(0)" ::: "memory");
    __syncthreads();
    if (threadIdx.x == 0) {
        unsigned* bar = b.bar;
        __builtin_amdgcn_s_waitcnt(0);
        unsigned nloc = b.st[0], nx = b.st[1];
        if (nloc == 0u) { xcd_barrier_complete(bar, b.x, nloc, nx); b.st[0] = nloc; b.st[1] = nx; }
        const unsigned old = xb_add(&bar[XB_XSUB(b.x)], 1u);
        const unsigned gen = old / nloc;
        if (old + 1u == (gen + 1u) * nloc) {
            __builtin_amdgcn_fence(__ATOMIC_RELEASE, "agent");
            asm volatile("s_waitcnt vmcnt(0)" ::: "memory");
            const unsigned og = xb_add(&bar[XB_TOP], 1u);
            const unsigned tg = og / nx;
            if (og + 1u == (tg + 1u) * nx) xb_add(&bar[XB_TOPGEN], 1u);
            else XB_SPIN(xb_ld(&bar[XB_TOPGEN]) == tg, bar);
            __builtin_amdgcn_fence(__ATOMIC_ACQUIRE, "agent");
            xb_add(&bar[XB_XGEN(b.x)], 1u);
            asm volatile("s_waitcnt vmcnt(0)" ::: "memory");
        } else {
            XB_SPIN(xb_ld(&bar[XB_XGEN(b.x)]) == gen, bar);
            __builtin_amdgcn_fence(__ATOMIC_ACQUIRE, "agent");
            asm volatile("s_waitcnt vmcnt(0)" ::: "memory");
        }
    }
    __syncthreads();
}

struct Args { const float* in[20]; float* out; unsigned char* ws; };
__global__ void __launch_bounds__(NTHREADS, 2) mk_fwd(Args args) {
    extern __shared__ __attribute__((aligned(16))) unsigned char lds_raw[];
    LAS unsigned char* lds = (LAS unsigned char*)lds_raw;
    cg::grid_group grid = cg::this_grid();
    const int tid = threadIdx.x, lane = tid & 63, wave = __builtin_amdgcn_readfirstlane(tid >> 6);
    const int G = gridDim.x, bx = blockIdx.x, vcu = (G % 8 == 0) ? (bx % 8) * (G / 8) + bx / 8 : bx;
    const int gw = vcu * NWAVES + wave, NGW = G * NWAVES;
    unsigned char* ws = args.ws;
    volatile LAS unsigned* xst = (volatile LAS unsigned*)(lds + LDS_BYTES - 64);
    if (tid < 2) xst[tid] = 0u;
    unsigned* barw = (unsigned*)ws;
    if (bx == 0) for (int i = tid; i < XCD_BAR_WORDS; i += NTHREADS) barw[i] = 0u;
    unsigned* pcnt = (unsigned*)(ws + WS_CNT / 2);
    if (tid < 3) for (int pm = bx; pm < M / 256; pm += G) pcnt[tid * 4096 + 16 * pm] = 0u;
    float* xbuf = (float*)(ws + WS_XBUF); float *rstd1 = xbuf + (size_t)M * 4, *rstd2 = rstd1 + M, *rstd0 = rstd2 + M;
    LAS unsigned char* tl = lds + 131072;
    const float* x = args.in[0];
    float* out = args.out;
    bf16 *Wgu1 = (bf16*)(ws + WS_WGU1), *Wd1 = (bf16*)(ws + WS_WD1), *Win = (bf16*)(ws + WS_WIN), *WA = (bf16*)(ws + WS_WA), *WB = (bf16*)(ws + WS_WB), *Wout = (bf16*)(ws + WS_WOUT),
         *Wgu2 = (bf16*)(ws + WS_WGU2), *Wd2 = (bf16*)(ws + WS_WD2);
    bf16 *XN = (bf16*)(ws + WS_XN), *UB = (bf16*)(ws + WS_U), *VG = (bf16*)(ws + WS_VG), *QB = (bf16*)(ws + WS_Q), *KB = (bf16*)(ws + WS_K), *VB = (bf16*)(ws + WS_V), *GB = (bf16*)(ws + WS_GB), *HB = (bf16*)(ws + WS_H);

    {
        LAS float* scr = (LAS float*)(lds + wave * 16384);
        constexpr int I_GU = (D / 64) * (FF / 32), I_DN = (FF / 64) * (D / 32), I_IN = (D / 64) * (DIN / 32), I_SQ = (D / 64) * (D / 32);
        constexpr int NITEMS = 4 * I_GU + 2 * I_DN + I_IN + 3 * I_SQ;
#define P0_ITEM(it_) do { int r = (it_); \
            if (r < I_GU) { p0_transpose_item(args.in[2], D, FF, Wgu1, 1, args.in[1], scr, r, lane); break; } r -= I_GU; \
            if (r < I_GU) { p0_transpose_item(args.in[3], D, FF, Wgu1, 2, args.in[1], scr, r, lane); break; } r -= I_GU; \
            if (r < I_DN) { p0_transpose_item(args.in[4], FF, D, Wd1, 0, nullptr, scr, r, lane); break; } r -= I_DN; \
            if (r < I_IN) { p0_transpose_item(args.in[6], D, DIN, Win, 0, args.in[5], scr, r, lane); break; } r -= I_IN; \
            if (r < I_SQ) { p0_transpose_item(args.in[12], D, D, WA, 0, nullptr, scr, r, lane); break; } r -= I_SQ; \
            if (r < I_SQ) { p0_transpose_item(args.in[13], D, D, WB, 0, nullptr, scr, r, lane); break; } r -= I_SQ; \
            if (r < I_SQ) { p0_transpose_item(args.in[14], D, D, Wout, 0, nullptr, scr, r, lane); break; } r -= I_SQ; \
            if (r < I_GU) { p0_transpose_item(args.in[16], D, FF, Wgu2, 1, args.in[15], scr, r, lane); break; } r -= I_GU; \
            if (r < I_GU) { p0_transpose_item(args.in[17], D, FF, Wgu2, 2, args.in[15], scr, r, lane); break; } r -= I_GU; \
            p0_transpose_item(args.in[18], FF, D, Wd2, 0, nullptr, scr, r, lane); } while (0)
        int it = gw;
        for (int m = gw; m < M; m += 2 * NGW) {
            const int m2 = m + NGW; const bool two = m2 < M;
            const GAS f32x4* xr = (const GAS f32x4*)(x + (size_t)m * D) + lane;
            const GAS f32x4* xs = (const GAS f32x4*)(x + (size_t)(two ? m2 : m) * D) + lane;
            f32x4 v[4], w[4];
#pragma unroll
            for (int j = 0; j < 4; ++j) { v[j] = xr[64 * j]; w[j] = xs[64 * j]; }
            if (it < NITEMS) { P0_ITEM(it); it += NGW; }
            float sa = 0.f, sb_ = 0.f;
#pragma unroll
            for (int j = 0; j < 4; ++j) { sa += (v[j].x * v[j].x + v[j].y * v[j].y) + (v[j].z * v[j].z + v[j].w * v[j].w); sb_ += (w[j].x * w[j].x + w[j].y * w[j].y) + (w[j].z * w[j].z + w[j].w * w[j].w); }
            const float rs = 1.0f / sqrtf(wave_sum(sa) * (1.f / D) + EPS), rt = 1.0f / sqrtf(wave_sum(sb_) * (1.f / D) + EPS);
            if (lane == 0) { rstd0[m] = rs; if (two) rstd0[m2] = rt; }
            GAS v2u* o = (GAS v2u*)(XN + ((size_t)(m >> 8) << 18) + (size_t)(m & 255) * 256) + lane; GAS v2u* o2 = (GAS v2u*)(XN + ((size_t)(m2 >> 8) << 18) + (size_t)(m2 & 255) * 256) + lane;
#pragma unroll
            for (int j = 0; j < 4; ++j) { const f32x4 y = v[j] * rs, z = w[j] * rt; v2u a, b; a.x = pk2(y.x, y.y); a.y = pk2(y.z, y.w); b.x = pk2(z.x, z.y); b.y = pk2(z.z, z.w); o[16384 * j] = a; if (two) o2[16384 * j] = b; }
        }
        for (; it < NITEMS; it += NGW) P0_ITEM(it);
#undef P0_ITEM
    }
    grid.sync();
    const XcdBarrier xb = xcd_barrier_post(barw, xst);
    { pg8::Gemm g{XN, Wgu1, M, NGU, D}; pg8::StaticOrder S; S.init(M, NGU, G, bx); pg8::EpiSwiglu E{HB, FF};
      pg8::gemm_phase<pg8::EpiSwiglu, pg8::StaticOrder, true, true, true>(lds, g, S, E); }
    xcd_barrier(xb);
    { pg8::Gemm g{HB, Wd1, M, D, FF}; pg8::StaticOrder S; S.init(M, D, G, bx); pg8::EpiResidNorm<0, true> E{XN, rstd0, XN, rstd1, 0.5f, xbuf, pcnt, tl};
      pg8::gemm_phase<pg8::EpiResidNorm<0, true>, pg8::StaticOrder, true, true>(lds, g, S, E); }
    xcd_barrier(xb);
    bf16 *KO = (bf16*)out, *VO = KO + (size_t)M * 1024, *GA = KB;
    { pg8::Gemm g{XN, Win, M, 2048, D}; pg8::StaticOrder S; S.init(M, 2048, G, bx); pg8::EpiProj<0> E{UB, VG, nullptr, nullptr, nullptr, nullptr, 1.f};
      pg8::gemm_phase<pg8::EpiProj<0>, pg8::StaticOrder, true, true, true>(lds, g, S, E); }
    { pg8::Gemm g{XN, Win + (size_t)2048 * D, M, 5120, D}; pg8::StaticOrder S; S.init(M, 5120, G, bx); pg8::EpiProj<1> E{QB, KO, VO, GA, GB, args.in[7], QSCALE};
      pg8::gemm_phase<pg8::EpiProj<1>, pg8::StaticOrder, true, true, true>(lds, g, S, E); }
    xcd_barrier(xb);
    gm::phase<false>(lds, UB, VG, args.in[8], args.in[9], args.in[10], args.in[11], vcu, G);
    sb::phase<false>(lds, QB, KO, VO, vcu, G);
    xcd_barrier(xb);
    { pg8::Gemm g{UB, WA, M, D, D}; pg8::StaticOrder S; S.init(M, D, G, bx); pg8::EpiGate<false> E{GA, nullptr, GA};
      pg8::gemm_phase<pg8::EpiGate<false>, pg8::StaticOrder, true, true>(lds, g, S, E); }
    { pg8::Gemm g{QB, WB, M, D, D}; pg8::StaticOrder S; S.init(M, D, G, bx); pg8::EpiGate<true> E{GB, GA, GB};
      pg8::gemm_phase<pg8::EpiGate<true>, pg8::StaticOrder, true, true>(lds, g, S, E); }
    xcd_barrier(xb);
    { pg8::Gemm g{GB, Wout, M, D, D}; pg8::StaticOrder S; S.init(M, D, G, bx); pg8::EpiResidNorm<0, true> E{XN, rstd1, XN, rstd2, 1.0f, xbuf, pcnt + 4096, tl};
      pg8::gemm_phase<pg8::EpiResidNorm<0, true>, pg8::StaticOrder, true, true>(lds, g, S, E); }
    xcd_barrier(xb);
    { pg8::Gemm g{XN, Wgu2, M, NGU, D}; pg8::StaticOrder S; S.init(M, NGU, G, bx); pg8::EpiSwiglu E{HB, FF};
      pg8::gemm_phase<pg8::EpiSwiglu, pg8::StaticOrder, true, true, true>(lds, g, S, E); }
    xcd_barrier(xb);
    { pg8::Gemm g{HB, Wd2, M, D, FF}; pg8::StaticOrder S; S.init(M, D, G, bx); pg8::EpiResidNorm<1, true> E{XN, rstd2, out, (float*)args.in[19], 0.5f, xbuf, pcnt + 8192, tl};
      pg8::gemm_phase<pg8::EpiResidNorm<1, true>, pg8::StaticOrder, true, true>(lds, g, S, E); }
}

extern "C" void kernel_launch(void* const* d_in, const int* in_sizes, int n_in, void* d_out, int out_size, void* d_ws, size_t ws_size, hipStream_t stream) {
    static int grid = 0;
    if (grid == 0) {
        if (n_in != 20 || in_sizes[0] != M * D || out_size != M * D || ws_size < WS_END) { fprintf(stderr, "kernel_launch: unexpected shapes / workspace (n_in %d, ws %zu)\n", n_in, ws_size); grid = -1; return; }
        int dev = 0, cus = 0, per_cu = 0;
        if (hipGetDevice(&dev) != hipSuccess || hipDeviceGetAttribute(&cus, hipDeviceAttributeMultiprocessorCount, dev) != hipSuccess) { grid = -1; return; }
        if (hipFuncSetAttribute((const void*)mk_fwd, hipFuncAttributeMaxDynamicSharedMemorySize, LDS_BYTES) != hipSuccess) { fprintf(stderr, "kernel_launch: hipFuncSetAttribute failed\n"); grid = -1; return; }
        if (hipOccupancyMaxActiveBlocksPerMultiprocessor(&per_cu, (const void*)mk_fwd, NTHREADS, LDS_BYTES) != hipSuccess || per_cu < 1) { fprintf(stderr, "kernel_launch: occupancy query says %d\n", per_cu); per_cu = 1; }
        (void)hipGetLastError();
        grid = cus;
    }
    if (grid < 0) return;
    Args a{};
    for (int i = 0; i < 20; ++i) a.in[i] = (const float*)d_in[i];
    a.out = (float*)d_out; a.ws = (unsigned char*)d_ws;
    void* kargs[] = {&a};
    hipError_t e = hipLaunchCooperativeKernel((const void*)mk_fwd, dim3(grid), dim3(NTHREADS), kargs, LDS_BYTES, stream);
    if (e != hipSuccess) fprintf(stderr, "kernel_launch: cooperative launch failed: %s (grid %d)\n", hipGetErrorString(e), grid);
}
```

```cpp
#include <hip/hip_runtime.h>
#include <hip/hip_cooperative_groups.h>
#include <cstdio>
#include <cstdint>
namespace cg = cooperative_groups;
namespace pg8 {
#define PG8_LAS __attribute__((address_space(3)))
typedef unsigned short bf16_t;
typedef short bf16x8 __attribute__((ext_vector_type(8)));
typedef float f32x4 __attribute__((ext_vector_type(4)));
typedef unsigned u32x4 __attribute__((ext_vector_type(4)));
constexpr int BM = 256, BK = 64, HALF = 128, HTB = HALF * BK * 2  , STAGE_BYTES = 8 * HTB, NXCD = 8, WGM = 8;

__host__ __device__ __forceinline__ int lds_byte(int r, int c) { const int st = (r >> 4) * 2 + (c >> 5), rr = r & 15, cc = c & 31, ob = rr * 64 + cc * 2; return st * 1024 + (ob ^ (((ob >> 9) & 1) << 5)); }
__host__ __device__ __forceinline__ void stage_rc(int b, int& R, int& C) { const int st = b / 1024, sb = b % 1024, swz = sb ^ (((sb >> 9) & 1) << 5); R = (st >> 1) * 16 + swz / 64; C = (st & 1) * 32 + (swz % 64) / 2; }
__host__ __device__ __forceinline__ int perm32(int rho) { const int n = rho >> 4, i = rho & 15; return 8 * (i >> 2) + 4 * n + (i & 3); }

struct Unit { int pm, pn; };
struct Gemm { const bf16_t* A; const bf16_t* Bt; int M, N, K; };

struct StaticOrder {
    int nM, nN, nwg, G, c;
    __host__ __device__ void init(int M, int N, int G_, int c_) { nM = M / BM; nN = N / BM; nwg = nM * nN; G = G_; c = c_; }
    __host__ __device__ bool next(int i, Unit& u) const {
        const long L = (long)i * G + c; if (L >= nwg) return false;
        int wgid = (int)L; { const int q = nwg / NXCD, r = nwg % NXCD, xcd = wgid % NXCD, off = wgid / NXCD; wgid = (xcd < r ? xcd * (q + 1) : r * (q + 1) + (xcd - r) * q) + off; }
        const int nig = WGM * nN, gid = wgid / nig, fm = gid * WGM, gsz = (nM - fm) < WGM ? (nM - fm) : WGM;
        u.pm = fm + ((wgid % nig) % gsz); u.pn = (wgid % nig) / gsz; return true;
    }
    __device__ __forceinline__ void a_ready(const Unit&) const {}
    __device__ __forceinline__ void done(const Unit&) const {}
};

typedef float cvt_f32x2 __attribute__((ext_vector_type(2))); typedef __bf16 cvt_bf16x2 __attribute__((ext_vector_type(2)));
__device__ __forceinline__ unsigned cvt_pk_bf16(float lo, float hi) { const cvt_f32x2 v = {lo, hi}; const cvt_bf16x2 b = __builtin_convertvector(v, cvt_bf16x2); return __builtin_bit_cast(unsigned, b); }
typedef float f32x2 __attribute__((ext_vector_type(2)));
__device__ __forceinline__ f32x2 gelu_pk(f32x2 v) {
    const f32x2 av = __builtin_elementwise_abs(v), d = av * 0.2316418882f + 1.0f;
    f32x2 t; t.x = __builtin_amdgcn_rcpf(d.x); t.y = __builtin_amdgcn_rcpf(d.y);
    f32x2 q = t * 0.5307027145f + (-0.7265760135f); q = q * t + 0.7107068705f; q = q * t + (-0.142248368f); q = q * t + 0.127414796f; q = q * t;
    const f32x2 s = (v * v) * (-0.72134752044f);
    f32x2 e; e.x = __builtin_amdgcn_exp2f(s.x); e.y = __builtin_amdgcn_exp2f(s.y);
    const f32x2 m = v * (q * e), r = v - m;
    f32x2 o; o.x = v.x < 0.f ? m.x : r.x; o.y = v.y < 0.f ? m.y : r.y; return o;
}

__device__ __forceinline__ float fast_sigmoid(float x) { return __builtin_amdgcn_rcpf(1.0f + __builtin_amdgcn_exp2f(-1.4426950408889634f * x)); }
__device__ __forceinline__ f32x2 sigmoid_pk(f32x2 x) { const f32x2 t = x * (-1.4426950408889634f); f32x2 e; e.x = __builtin_amdgcn_exp2f(t.x); e.y = __builtin_amdgcn_exp2f(t.y); const f32x2 d = e + 1.0f; f32x2 r; r.x = __builtin_amdgcn_rcpf(d.x); r.y = __builtin_amdgcn_rcpf(d.y); return r; }
__device__ __forceinline__ float bf_lo(unsigned w) { return __uint_as_float(w << 16); }
__device__ __forceinline__ float bf_hi(unsigned w) { return __uint_as_float(w & 0xffff0000u); }
struct EpiSwiglu {
    static constexpr bool PERM = true, AFTER_DRAIN = false;
    bf16_t* O; int ldc;
    __device__ __forceinline__ void operator()(const f32x4 (&acc)[2][2][4][2], const Unit& u, int wr, int wc, int fr, int fq) const {
        const int row0 = u.pm * BM + wr * 64 + fr, col0 = u.pn * HALF + wc * 32 + 8 * fq;
#pragma unroll
        for (int ai = 0; ai < 2; ++ai)
#pragma unroll
            for (int m = 0; m < 4; ++m) {
                bf16_t* rowp = O + (size_t)(row0 + ai * HALF + m * 16) * ldc + col0;
                f32x2 h[4];
#pragma unroll
                for (int n = 0; n < 2; ++n)
#pragma unroll
                    for (int e = 0; e < 2; ++e) { const f32x2 g = (f32x2){acc[ai][0][m][n][2 * e], acc[ai][0][m][n][2 * e + 1]}, up = (f32x2){acc[ai][1][m][n][2 * e], acc[ai][1][m][n][2 * e + 1]}; h[n * 2 + e] = (g * sigmoid_pk(g)) * up; }
                u32x4 w; w.x = cvt_pk_bf16(h[0].x, h[0].y); w.y = cvt_pk_bf16(h[1].x, h[1].y); w.z = cvt_pk_bf16(h[2].x, h[2].y); w.w = cvt_pk_bf16(h[3].x, h[3].y);
                *(u32x4*)rowp = w;
            }
    }
};
struct EpiResid {
    static constexpr bool PERM = false, AFTER_DRAIN = false;
    const float* base; float* out; int ldc; float alpha;
    __device__ __forceinline__ void operator()(const f32x4 (&acc)[2][2][4][2], const Unit& u, int wr, int wc, int fr, int fq) const {
        const int row0 = u.pm * BM + wr * 64 + fr, col0 = u.pn * BM + wc * 32 + 4 * fq;
#pragma unroll
        for (int ai = 0; ai < 2; ++ai)
#pragma unroll
            for (int m = 0; m < 4; ++m) {
                const size_t off = (size_t)(row0 + ai * HALF + m * 16) * ldc + col0;
#pragma unroll
                for (int bj = 0; bj < 2; ++bj)
#pragma unroll
                    for (int n = 0; n < 2; ++n) { const f32x4 b = *(const f32x4*)(base + off + bj * HALF + n * 16); *(f32x4*)(out + off + bj * HALF + n * 16) = b + acc[ai][bj][m][n] * alpha; }
            }
    }
};
template <int MODE, bool BASE_BF16> struct EpiResidNorm {
    static constexpr bool PERM = true, AFTER_DRAIN = false, TOUCH = false;
    const bf16_t* baseb; const float* rstd_in; void* dst; float* aux; float alpha; float* xbuf; unsigned* cnt; PG8_LAS unsigned char* tl;
    __device__ __forceinline__ void operator()(f32x4 (&acc)[2][2][4][2], const Unit& u, int wr, int wc, int fr, int fq) const {
        static_assert(BASE_BF16, "the residual base is the tile-major bf16 stream");
        int tix = threadIdx.x; asm volatile("" : "+v"(tix));
        const int lane = tix & 63, wid = __builtin_amdgcn_readfirstlane(tix >> 6);
        PG8_LAS float* P = (PG8_LAS float*)tl; PG8_LAS float* S = (PG8_LAS float*)(tl + 4096);
        const int row0 = u.pm * BM + wr * 64 + fr, col0 = u.pn * BM + wc * 32 + 8 * fq;
        const size_t toff = ((size_t)(u.pm * 4 + u.pn) << 16) + (size_t)((wr * 64 + fr) * 256 + wc * 32 + 8 * fq);
#pragma unroll
        for (int ai = 0; ai < 2; ++ai)
#pragma unroll
            for (int m = 0; m < 4; ++m) {
                float s = 0.f; const float rin = __builtin_amdgcn_rcpf(rstd_in[row0 + ai * HALF + m * 16]);
#pragma unroll
                for (int bj = 0; bj < 2; ++bj) { const u32x4 w = *(const u32x4*)(baseb + toff + (size_t)((ai * HALF + m * 16) * 256 + bj * HALF));
                    const f32x4 b0 = (f32x4){bf_lo(w.x), bf_hi(w.x), bf_lo(w.y), bf_hi(w.y)} * rin, b1 = (f32x4){bf_lo(w.z), bf_hi(w.z), bf_lo(w.w), bf_hi(w.w)} * rin;
                    const f32x4 v0 = b0 + acc[ai][bj][m][0] * alpha, v1 = b1 + acc[ai][bj][m][1] * alpha; acc[ai][bj][m][0] = v0; acc[ai][bj][m][1] = v1;
                    s += ((v0[0] * v0[0] + v0[1] * v0[1]) + (v0[2] * v0[2] + v0[3] * v0[3])) + ((v1[0] * v1[0] + v1[1] * v1[1]) + (v1[2] * v1[2] + v1[3] * v1[3])); }
                s += __shfl_xor(s, 16); s += __shfl_xor(s, 32);
                if (fq == 0) P[(ai * HALF + wr * 64 + m * 16 + fr) * 4 + wc] = s;
                if (m & 1) asm volatile("" ::: "memory");
            }
        asm volatile("s_waitcnt lgkmcnt(0)" ::: "memory"); __builtin_amdgcn_s_barrier(); asm volatile("" ::: "memory");
        const int row = wid * 32 + (lane & 31);
        float* slot = xbuf + ((size_t)(u.pm * BM + row) * 4);
        if (lane < 32) { const f32x4 p = *(const PG8_LAS f32x4*)(P + row * 4); __hip_atomic_store(slot + u.pn, (p[0] + p[1]) + (p[2] + p[3]), __ATOMIC_RELAXED, __HIP_MEMORY_SCOPE_AGENT); }
        asm volatile("s_waitcnt vmcnt(0)" ::: "memory");
        unsigned* c = cnt + 16 * u.pm;
        if (lane == 0) __hip_atomic_fetch_add(c, 1u, __ATOMIC_RELAXED, __HIP_MEMORY_SCOPE_AGENT);
        if (wid == 0) {
            unsigned sp = 0;
            while ((unsigned)__builtin_amdgcn_readfirstlane(__hip_atomic_load(c, __ATOMIC_RELAXED, __HIP_MEMORY_SCOPE_AGENT)) < 32u) { __builtin_amdgcn_s_sleep(2); if (++sp > (1u << 22)) break; }
            __builtin_amdgcn_fence(__ATOMIC_ACQUIRE, "agent");
        }
        asm volatile("s_waitcnt vmcnt(0) lgkmcnt(0)" ::: "memory"); __builtin_amdgcn_s_barrier(); asm volatile("" ::: "memory");
        if (lane < 32) { const float a = __hip_atomic_load(slot + 0, __ATOMIC_RELAXED, __HIP_MEMORY_SCOPE_AGENT), b = __hip_atomic_load(slot + 1, __ATOMIC_RELAXED, __HIP_MEMORY_SCOPE_AGENT),
                                     cc = __hip_atomic_load(slot + 2, __ATOMIC_RELAXED, __HIP_MEMORY_SCOPE_AGENT), d = __hip_atomic_load(slot + 3, __ATOMIC_RELAXED, __HIP_MEMORY_SCOPE_AGENT);
            const float rs = __builtin_amdgcn_rsqf(((a + b) + (cc + d)) * (1.0f / 1024.0f) + 1e-6f); S[row] = rs;
            if (MODE == 0 && u.pn == 0) aux[u.pm * BM + row] = rs; }
        asm volatile("s_waitcnt lgkmcnt(0)" ::: "memory"); __builtin_amdgcn_s_barrier(); asm volatile("" ::: "memory");
        f32x4 gv[2][2];
#pragma unroll
        for (int bj = 0; bj < 2; ++bj)
#pragma unroll
            for (int n = 0; n < 2; ++n) gv[bj][n] = (MODE == 1) ? *(const f32x4*)(aux + col0 + bj * HALF + n * 4) : (f32x4){1.f, 1.f, 1.f, 1.f};
#pragma unroll
        for (int ai = 0; ai < 2; ++ai)
#pragma unroll
            for (int m = 0; m < 4; ++m) {
                const float rs = S[ai * HALF + wr * 64 + m * 16 + fr]; const size_t off = (size_t)(row0 + ai * HALF + m * 16) * 1024 + col0;
#pragma unroll
                for (int bj = 0; bj < 2; ++bj) {
                    if (MODE == 1) { float* out = (float*)dst; *(f32x4*)(out + off + bj * HALF) = acc[ai][bj][m][0] * rs * gv[bj][0]; *(f32x4*)(out + off + bj * HALF + 4) = acc[ai][bj][m][1] * rs * gv[bj][1]; }
                    else { const f32x4 y0 = acc[ai][bj][m][0] * rs, y1 = acc[ai][bj][m][1] * rs; u32x4 w; w.x = cvt_pk_bf16(y0[0], y0[1]); w.y = cvt_pk_bf16(y0[2], y0[3]); w.z = cvt_pk_bf16(y1[0], y1[1]); w.w = cvt_pk_bf16(y1[2], y1[3]);
                        *(u32x4*)((bf16_t*)dst + toff + (size_t)((ai * HALF + m * 16) * 256 + bj * HALF)) = w; } }
                if (m & 1) asm volatile("" ::: "memory");
            }
    }
};
struct EpiNull { static constexpr bool PERM = true, AFTER_DRAIN = false; float* sink;
    __device__ __forceinline__ void operator()(f32x4 (&acc)[2][2][4][2], const Unit& u, int wr, int wc, int fr, int fq) const { f32x4 t = {0.f, 0.f, 0.f, 0.f};
#pragma unroll
        for (int a = 0; a < 2; ++a)
#pragma unroll
            for (int b = 0; b < 2; ++b)
#pragma unroll
                for (int m = 0; m < 4; ++m)
#pragma unroll
                    for (int n = 0; n < 2; ++n) t += acc[a][b][m][n];
        if (t[0] + t[1] + t[2] + t[3] == 12345.678f) sink[0] = t[0]; } };
template <int KIND> struct EpiProj {
    static constexpr bool PERM = true, AFTER_DRAIN = false;
    bf16_t *d0, *d1, *d2, *d3, *d4; const float* bias; float qscale;
    __device__ __forceinline__ void operator()(const f32x4 (&acc)[2][2][4][2], const Unit& u, int wr, int wc, int fr, int fq) const {
        const int seg = u.pn >> 2, colt = (u.pn & 3) * BM;
        bf16_t* dst = seg == 0 ? d0 : seg == 1 ? d1 : seg == 2 ? d2 : seg == 3 ? d3 : d4;
        const int row0 = u.pm * BM + wr * 64 + fr, col0 = colt + wc * 32 + 8 * fq;
        const int mode = (KIND == 0) ? 1 : (seg == 0 ? 2 : (seg >= 3 ? 3 : 0));
        f32x4 bv[2][2];
#pragma unroll
        for (int bj = 0; bj < 2; ++bj)
#pragma unroll
            for (int n = 0; n < 2; ++n) bv[bj][n] = (KIND == 1 && mode == 3) ? *(const f32x4*)(bias + (seg - 3) * 1024 + col0 + bj * HALF + 4 * n) : (f32x4){0.f, 0.f, 0.f, 0.f};
#pragma unroll
        for (int ai = 0; ai < 2; ++ai)
#pragma unroll
            for (int m = 0; m < 4; ++m) { bf16_t* rowp = dst + (size_t)(row0 + ai * HALF + m * 16) * 1024 + col0;
#pragma unroll
                for (int bj = 0; bj < 2; ++bj) { f32x4 v0 = acc[ai][bj][m][0], v1 = acc[ai][bj][m][1];
                    if (mode == 1) { f32x2 a = gelu_pk((f32x2){v0[0], v0[1]}), b = gelu_pk((f32x2){v0[2], v0[3]}), c = gelu_pk((f32x2){v1[0], v1[1]}), d = gelu_pk((f32x2){v1[2], v1[3]});
                        v0 = (f32x4){a.x, a.y, b.x, b.y}; v1 = (f32x4){c.x, c.y, d.x, d.y}; }
                    else if (mode == 2) { v0 = v0 * qscale; v1 = v1 * qscale; }
                    else if (mode == 3) { v0 = v0 + bv[bj][0]; v1 = v1 + bv[bj][1];
#pragma unroll
                        for (int e = 0; e < 1; ++e) { const f32x2 a = sigmoid_pk((f32x2){v0[0], v0[1]}), b = sigmoid_pk((f32x2){v0[2], v0[3]}), c = sigmoid_pk((f32x2){v1[0], v1[1]}), d = sigmoid_pk((f32x2){v1[2], v1[3]}); v0 = (f32x4){a.x, a.y, b.x, b.y}; v1 = (f32x4){c.x, c.y, d.x, d.y}; } }
                    u32x4 w; w.x = cvt_pk_bf16(v0[0], v0[1]); w.y = cvt_pk_bf16(v0[2], v0[3]); w.z = cvt_pk_bf16(v1[0], v1[1]); w.w = cvt_pk_bf16(v1[2], v1[3]);
                    *(u32x4*)(rowp + bj * HALF) = w; } }
    }
};
template <bool ADD> struct EpiGate {
    static constexpr bool PERM = true, AFTER_DRAIN = false;
    const bf16_t* gate; const bf16_t* add; bf16_t* dst;
    __device__ __forceinline__ void operator()(const f32x4 (&acc)[2][2][4][2], const Unit& u, int wr, int wc, int fr, int fq) const {
        const int row0 = u.pm * BM + wr * 64 + fr, col0 = u.pn * BM + wc * 32 + 8 * fq;
#pragma unroll
        for (int ai = 0; ai < 2; ++ai)
#pragma unroll
            for (int m = 0; m < 4; ++m) { const size_t off = (size_t)(row0 + ai * HALF + m * 16) * 1024 + col0;
#pragma unroll
                for (int bj = 0; bj < 2; ++bj) { const f32x4 v0 = acc[ai][bj][m][0], v1 = acc[ai][bj][m][1];
                    const u32x4 g = *(const u32x4*)(gate + off + bj * HALF);
                    float r[8] = { bf_lo(g.x) * v0[0], bf_hi(g.x) * v0[1], bf_lo(g.y) * v0[2], bf_hi(g.y) * v0[3], bf_lo(g.z) * v1[0], bf_hi(g.z) * v1[1], bf_lo(g.w) * v1[2], bf_hi(g.w) * v1[3] };
                    if (ADD) { const u32x4 a = *(const u32x4*)(add + off + bj * HALF);
                        r[0] += bf_lo(a.x); r[1] += bf_hi(a.x); r[2] += bf_lo(a.y); r[3] += bf_hi(a.y); r[4] += bf_lo(a.z); r[5] += bf_hi(a.z); r[6] += bf_lo(a.w); r[7] += bf_hi(a.w); }
                    u32x4 w; w.x = cvt_pk_bf16(r[0], r[1]); w.y = cvt_pk_bf16(r[2], r[3]); w.z = cvt_pk_bf16(r[4], r[5]); w.w = cvt_pk_bf16(r[6], r[7]);
                    *(u32x4*)(dst + off + bj * HALF) = w; } }
    }
};

template <class Epi, class Sched, bool ALIGN_EPI = false, bool SP2 = false, bool TILED_A = false>
__device__ __forceinline__ void gemm_phase(PG8_LAS unsigned char* lds, const Gemm g, const Sched& S, const Epi& E) {
    int tid_ = threadIdx.x; asm volatile("" : "+v"(tid_));
    const int tid = tid_, wid = __builtin_amdgcn_readfirstlane(tid >> 6), lane = tid & 63, wr = wid >> 2, wc = wid & 3, fr = lane & 15, fq = lane >> 4;
    const int K = g.K, nt = K / BK;
    unsigned voffA[2], voffB[2];
#pragma unroll
    for (int i = 0; i < 2; ++i) { int R, C; stage_rc(tid * 16 + i * 8192, R, C); const int Rb = Epi::PERM ? ((R & ~31) + perm32(R & 31)) : R;
        voffA[i] = (unsigned)(R * (TILED_A ? 256 : K) + C) * 2u; voffB[i] = (unsigned)(Rb * K + C) * 2u; }
    const size_t kstep = (size_t)(BK * 2);
    const size_t hstep = (size_t)HALF * K * 2;
    const size_t tstep = 2 * hstep;
    const size_t hstepA = TILED_A ? (size_t)HALF * 256 * 2 : hstep;
#define PG8_KOFS(t_) (TILED_A ? ((size_t)((t_) >> 2) * 131072 + (size_t)((t_) & 3) * 128) : (size_t)(t_) * kstep)
    const unsigned ldsw = (unsigned)wid * 1024u;
    const int aoff = lds_byte(wr * 64 + fr, fq * 8), boff = lds_byte(wc * 32 + fr, fq * 8);
#define PG8_SA(b, h) (((b) * 2 + (h)) * HTB)
#define PG8_SB(b, h) ((4 + (b) * 2 + (h)) * HTB)
#define PG8_STAGE(bufoff, gbase, voff) do { _Pragma("unroll") for (int _i = 0; _i < 2; ++_i) \
        __builtin_amdgcn_global_load_lds((const unsigned*)((const char*)(gbase) + (voff)[_i]), (PG8_LAS unsigned*)(lds + (bufoff) + ldsw + _i * 8192), 16, 0, 0); } while (0)
#define PG8_LDA(dst, b, h) do { _Pragma("unroll") for (int m = 0; m < 4; ++m) _Pragma("unroll") for (int k = 0; k < 2; ++k) dst[m][k] = *(const PG8_LAS bf16x8*)(lds + PG8_SA(b, h) + aoff + m * 2048 + k * 1024); } while (0)
#define PG8_LDB(dst, b, h) do { _Pragma("unroll") for (int n = 0; n < 2; ++n) _Pragma("unroll") for (int k = 0; k < 2; ++k) dst[n][k] = *(const PG8_LAS bf16x8*)(lds + PG8_SB(b, h) + boff + n * 2048 + k * 1024); } while (0)
#define PG8_MMA(ai, bj, At, Bt) do { __builtin_amdgcn_s_setprio(1); _Pragma("unroll") for (int m = 0; m < 4; ++m) _Pragma("unroll") for (int n = 0; n < 2; ++n) _Pragma("unroll") for (int k = 0; k < 2; ++k) \
        acc[ai][bj][m][n] = __builtin_amdgcn_mfma_f32_16x16x32_bf16(Bt[n][k], At[m][k], acc[ai][bj][m][n], 0, 0, 0); __builtin_amdgcn_s_setprio(0); } while (0)
#define PG8_WAIT_V(n) asm volatile("s_waitcnt vmcnt(" #n ")" ::: "memory")
#define PG8_WAIT_L(n) asm volatile("s_waitcnt lgkmcnt(" #n ")" ::: "memory")
#define PG8_BAR __builtin_amdgcn_s_barrier()
#define PG8_SCHED __builtin_amdgcn_sched_barrier(0)
    Unit cur, nxt; int ui = 0;
    if (!S.next(0, cur)) return;
    f32x4 acc[2][2][4][2];
#pragma unroll
    for (int a = 0; a < 2; ++a)
#pragma unroll
        for (int b = 0; b < 2; ++b)
#pragma unroll
            for (int m = 0; m < 4; ++m)
#pragma unroll
                for (int n = 0; n < 2; ++n) acc[a][b][m][n] = (f32x4){0.f, 0.f, 0.f, 0.f};
    bf16x8 At[4][2], B0[2][2], B1[2][2];
    const char* cA = (const char*)g.A + (size_t)cur.pm * tstep; const char* cB = (const char*)g.Bt + (size_t)cur.pn * tstep;
    S.a_ready(cur);
    if constexpr (SP2) {
        PG8_STAGE(PG8_SB(0, 0), cB, voffB); PG8_STAGE(PG8_SB(0, 1), cB + hstep, voffB); PG8_STAGE(PG8_SA(0, 0), cA, voffA); PG8_STAGE(PG8_SA(0, 1), cA + hstepA, voffA);
        if (wr == 1) PG8_BAR;
        PG8_WAIT_V(2); PG8_BAR;
        PG8_STAGE(PG8_SB(1, 0), cB + kstep, voffB); PG8_STAGE(PG8_SA(1, 0), cA + kstep, voffA); PG8_STAGE(PG8_SB(1, 1), cB + hstep + kstep, voffB);
        PG8_WAIT_V(6); PG8_BAR;
    } else {
        PG8_STAGE(PG8_SB(0, 0), cB, voffB); PG8_STAGE(PG8_SA(0, 0), cA, voffA); PG8_STAGE(PG8_SB(0, 1), cB + hstep, voffB); PG8_STAGE(PG8_SA(0, 1), cA + hstepA, voffA);
        if (wr == 1) PG8_BAR;
        PG8_WAIT_V(4); PG8_BAR;
        PG8_STAGE(PG8_SB(1, 0), cB + kstep, voffB); PG8_STAGE(PG8_SA(1, 0), cA + kstep, voffA); PG8_STAGE(PG8_SB(1, 1), cB + hstep + kstep, voffB);
        PG8_WAIT_V(6); PG8_BAR;
    }
    for (;;) {
        const bool has_next = S.next(ui + 1, nxt);
        const char* nA = has_next ? (const char*)g.A + (size_t)nxt.pm * tstep : cA; const char* nB = has_next ? (const char*)g.Bt + (size_t)nxt.pn * tstep : cB;
        for (int t = 0; t < nt; t += 2) {
            const bool last = (t == nt - 2);
            const char* a1 = cA + PG8_KOFS(t + 1);
            const char* a2 = last ? nA : cA + PG8_KOFS(t + 2); const char* b2 = last ? nB : cB + (size_t)(t + 2) * kstep;
            const char* a3 = a2 + kstep; const char* b3 = b2 + kstep;
            if (last && has_next) S.a_ready(nxt);
            if constexpr (SP2) {
            PG8_LDB(B0, 0, 0); PG8_LDB(B1, 0, 1); PG8_SCHED; PG8_LDA(At, 0, 0); PG8_STAGE(PG8_SA(1, 1), a1 + hstepA, voffA);
            PG8_WAIT_V(8); PG8_WAIT_L(0); PG8_BAR; PG8_MMA(0, 0, At, B0); PG8_MMA(0, 1, At, B1); PG8_BAR; PG8_SCHED;
            PG8_LDA(At, 0, 1); PG8_STAGE(PG8_SB(0, 0), b2, voffB); PG8_STAGE(PG8_SB(0, 1), b2 + hstep, voffB); PG8_STAGE(PG8_SA(0, 0), a2, voffA);
            PG8_WAIT_V(8); PG8_WAIT_L(0); PG8_BAR; PG8_MMA(1, 0, At, B0); PG8_MMA(1, 1, At, B1); PG8_BAR; PG8_SCHED;
            PG8_LDB(B0, 1, 0); PG8_LDB(B1, 1, 1); PG8_SCHED; PG8_LDA(At, 1, 0); PG8_STAGE(PG8_SA(0, 1), a2 + hstepA, voffA);
            PG8_WAIT_V(8); PG8_WAIT_L(0); PG8_BAR; PG8_MMA(0, 0, At, B0); PG8_MMA(0, 1, At, B1); PG8_BAR; PG8_SCHED;
            PG8_LDA(At, 1, 1); PG8_STAGE(PG8_SB(1, 0), b3, voffB); PG8_STAGE(PG8_SB(1, 1), b3 + hstep, voffB); PG8_STAGE(PG8_SA(1, 0), a3, voffA);
            PG8_WAIT_V(8); PG8_WAIT_L(0); PG8_BAR; PG8_MMA(1, 0, At, B0); PG8_MMA(1, 1, At, B1); PG8_BAR; PG8_SCHED;
            } else {
            PG8_LDB(B0, 0, 0); PG8_SCHED; PG8_LDA(At, 0, 0); PG8_STAGE(PG8_SA(1, 1), a1 + hstepA, voffA);
            PG8_WAIT_L(8); PG8_BAR; PG8_WAIT_L(0); PG8_MMA(0, 0, At, B0); PG8_BAR; PG8_SCHED;
            PG8_LDB(B1, 0, 1); PG8_STAGE(PG8_SB(0, 0), b2, voffB);
            PG8_BAR; PG8_WAIT_L(0); PG8_MMA(0, 1, At, B1); PG8_BAR;
            PG8_LDA(At, 0, 1); PG8_STAGE(PG8_SA(0, 0), a2, voffA);
            PG8_BAR; PG8_WAIT_L(0); PG8_MMA(1, 0, At, B0); PG8_BAR; PG8_SCHED;
            PG8_STAGE(PG8_SB(0, 1), b2 + hstep, voffB);
            PG8_WAIT_V(6); PG8_BAR; PG8_MMA(1, 1, At, B1); PG8_BAR;
            PG8_LDB(B0, 1, 0); PG8_SCHED; PG8_LDA(At, 1, 0); PG8_STAGE(PG8_SA(0, 1), a2 + hstepA, voffA);
            PG8_WAIT_L(8); PG8_BAR; PG8_WAIT_L(0); PG8_MMA(0, 0, At, B0); PG8_BAR; PG8_SCHED;
            PG8_LDB(B1, 1, 1); PG8_STAGE(PG8_SB(1, 0), b3, voffB);
            PG8_BAR; PG8_WAIT_L(0); PG8_MMA(0, 1, At, B1); PG8_BAR;
            PG8_LDA(At, 1, 1); PG8_STAGE(PG8_SA(1, 0), a3, voffA);
            PG8_BAR; PG8_WAIT_L(0); PG8_MMA(1, 0, At, B0); PG8_BAR; PG8_SCHED;
            PG8_STAGE(PG8_SB(1, 1), b3 + hstep, voffB);
            PG8_WAIT_V(6); PG8_BAR; PG8_MMA(1, 1, At, B1); PG8_BAR;
            }
        }
        if constexpr (ALIGN_EPI) { if (wr == 0) PG8_BAR; }
        if constexpr (!Epi::AFTER_DRAIN) { E(acc, cur, wr, wc, fr, fq); S.done(cur); }
        if (!has_next) break;
#pragma unroll
        for (int a = 0; a < 2; ++a)
#pragma unroll
            for (int b = 0; b < 2; ++b)
#pragma unroll
                for (int m = 0; m < 4; ++m)
#pragma unroll
                    for (int n = 0; n < 2; ++n) acc[a][b][m][n] = (f32x4){0.f, 0.f, 0.f, 0.f};
        cur = nxt; cA = nA; cB = nB; ++ui;
        if constexpr (ALIGN_EPI) { if (wr == 1) PG8_BAR; }
    }
    PG8_WAIT_V(0);
    if constexpr (!ALIGN_EPI) { if (wr == 0) PG8_BAR; }
    PG8_BAR;
    if constexpr (Epi::AFTER_DRAIN) { E.fused(acc, cur, wr, wc, fr, fq, lds, wid, lane); S.done(cur); }
#undef PG8_SA
#undef PG8_SB
#undef PG8_STAGE
#undef PG8_LDA
#undef PG8_LDB
#undef PG8_MMA
#undef PG8_WAIT_V
#undef PG8_WAIT_L
#undef PG8_BAR
#undef PG8_SCHED
#undef PG8_KOFS
}
}
#define GAS __attribute__((address_space(1)))
#define LAS __attribute__((address_space(3)))
typedef unsigned short bf16;
typedef unsigned v4u __attribute__((ext_vector_type(4)));
typedef unsigned v2u __attribute__((ext_vector_type(2)));
typedef float f32x4 __attribute__((ext_vector_type(4)));
typedef float f32x16 __attribute__((ext_vector_type(16)));
typedef short bf16x8 __attribute__((ext_vector_type(8)));
typedef short s16x4 __attribute__((ext_vector_type(4)));

constexpr int NWAVES = 8, NTHREADS = 512;
constexpr int BATCH = 32, SEQ = 2048, D = 1024, FF = 2816, M = BATCH * SEQ;
constexpr int NGU = 2 * FF;
constexpr int DIN = 7168;
constexpr float EPS = 1e-6f;
constexpr size_t MiB = 1u << 20;
constexpr size_t WS_WGU1 = 2 * MiB, WS_WD1 = 13 * MiB, WS_WIN = 19 * MiB, WS_WA = 33 * MiB, WS_WB = 35 * MiB, WS_WOUT = 37 * MiB, WS_WGU2 = 39 * MiB, WS_WD2 = 50 * MiB;
constexpr size_t WS_XN = 64 * MiB;
constexpr size_t WS_U = 192 * MiB;
constexpr size_t WS_VG = 320 * MiB;
constexpr size_t WS_Q = 448 * MiB;
constexpr size_t WS_K = 576 * MiB, WS_V = 704 * MiB;
constexpr size_t WS_GB = 832 * MiB;
constexpr size_t WS_H = 192 * MiB;
constexpr size_t WS_XBUF = 960 * MiB;
constexpr size_t WS_CNT = 1 * MiB;
constexpr size_t WS_END = 962 * MiB;
constexpr int LDS_BYTES = 147456;
constexpr float QSCALE = 0.125f * 1.4426950408889634f;

__device__ __forceinline__ unsigned f2bf(float f) { unsigned u = __builtin_bit_cast(unsigned, f); return (u + 0x7fffu + ((u >> 16) & 1u)) >> 16; }
__device__ __forceinline__ unsigned pk2(float lo, float hi) { return f2bf(lo) | (f2bf(hi) << 16); }
__device__ __forceinline__ float bflo(unsigned w) { return __uint_as_float(w << 16); }
__device__ __forceinline__ float bfhi(unsigned w) { return __uint_as_float(w & 0xffff0000u); }
__device__ __forceinline__ float wave_sum(float v) {
#pragma unroll
    for (int o = 1; o < 64; o <<= 1) v += __shfl_xor(v, o);
    return v;
}
#define LDS_WAIT() asm volatile("s_waitcnt lgkmcnt(0)" ::: "memory")

__device__ __forceinline__ void p0_transpose_item(const float* W, int K, int N, bf16* WT, int mode, const float* gain, LAS float* scr, int item, int lane) {
    const int nblk = N / 32, kb = item / nblk, nb = item % nblk, k0 = 64 * kb, n0 = 32 * nb;
    const int row0 = (mode == 0) ? n0 : (256 * (n0 >> 7) + (n0 & 127) + (mode == 2 ? 128 : 0));
#pragma unroll 8
    for (int i = 0; i < 32; ++i) { const int kk = 2 * i + (lane >> 5); scr[kk * 33 + (lane & 31)] = W[(size_t)(k0 + kk) * N + n0 + (lane & 31)] * (gain ? gain[k0 + kk] : 1.0f); }
    LDS_WAIT(); asm volatile("" ::: "memory");
    const int c = lane & 7;
#pragma unroll
    for (int j = 0; j < 4; ++j) { const int n = (lane >> 3) + 8 * j; const LAS float* s = scr + (8 * c) * 33 + n;
        v4u o; o.x = pk2(s[0 * 33], s[1 * 33]); o.y = pk2(s[2 * 33], s[3 * 33]); o.z = pk2(s[4 * 33], s[5 * 33]); o.w = pk2(s[6 * 33], s[7 * 33]);
        *(GAS v4u*)(WT + (size_t)(row0 + n) * K + k0 + 8 * c) = o; }
    LDS_WAIT(); asm volatile("" ::: "memory");
}
template <bool TO_F32> __device__ __forceinline__ void rms_rows(const float* X, const float* gain, void* out, float* rstd_out, int gw, int NGW, int lane) {
    f32x4 g[4];
#pragma unroll
    for (int j = 0; j < 4; ++j) g[j] = gain ? *((const f32x4*)gain + lane + 64 * j) : (f32x4){1.f, 1.f, 1.f, 1.f};
    for (int m = gw; m < M; m += 2 * NGW) {
        const int m2 = m + NGW;
        const bool two = m2 < M;
        const GAS f32x4* xr = (const GAS f32x4*)(X + (size_t)m * D) + lane;
        const GAS f32x4* xs = (const GAS f32x4*)(X + (size_t)(two ? m2 : m) * D) + lane;
        f32x4 v[4], w[4]; float s = 0.f, t = 0.f;
#pragma unroll
        for (int j = 0; j < 4; ++j) { v[j] = xr[64 * j]; w[j] = xs[64 * j]; }
#pragma unroll
        for (int j = 0; j < 4; ++j) { s += (v[j].x * v[j].x + v[j].y * v[j].y) + (v[j].z * v[j].z + v[j].w * v[j].w); t += (w[j].x * w[j].x + w[j].y * w[j].y) + (w[j].z * w[j].z + w[j].w * w[j].w); }
        const float rs = 1.0f / sqrtf(wave_sum(s) * (1.f / D) + EPS), rt = 1.0f / sqrtf(wave_sum(t) * (1.f / D) + EPS);
        if (rstd_out && lane == 0) { rstd_out[m] = rs; if (two) rstd_out[m2] = rt; }
        if (TO_F32) { GAS f32x4* o = (GAS f32x4*)((float*)out + (size_t)m * D) + lane; GAS f32x4* o2 = (GAS f32x4*)((float*)out + (size_t)m2 * D) + lane;
#pragma unroll
            for (int j = 0; j < 4; ++j) { o[64 * j] = v[j] * rs * g[j]; if (two) o2[64 * j] = w[j] * rt * g[j]; } }
        else { GAS v2u* o = (GAS v2u*)((bf16*)out + ((size_t)(m >> 8) << 18) + (size_t)(m & 255) * 256) + lane; GAS v2u* o2 = (GAS v2u*)((bf16*)out + ((size_t)(m2 >> 8) << 18) + (size_t)(m2 & 255) * 256) + lane;
#pragma unroll
            for (int j = 0; j < 4; ++j) { const f32x4 y = v[j] * rs * g[j], z = w[j] * rt * g[j]; v2u a, b; a.x = pk2(y.x, y.y); a.y = pk2(y.z, y.w); b.x = pk2(z.x, z.y); b.y = pk2(z.z, z.w); o[16384 * j] = a; if (two) o2[16384 * j] = b; } }
    }
}

namespace gm {
constexpr int VP = 576;
constexpr int SP = 528;
constexpr int OFF_V = 0, OFF_S = 128 * VP;
static_assert(OFF_S + 128 * SP <= 147456, "gmlp LDS");
__device__ __forceinline__ int crow(int r, int hi) { return (r & 3) + 8 * (r >> 2) + 4 * hi; }
template <bool DRY> __device__ __forceinline__ void phase(LAS unsigned char* lds, bf16* U, const bf16* VG, const float* ln_g, const float* ln_b, const float* w_s, const float* b_s, int vcu, int G) {
    const int tid = threadIdx.x, lane = tid & 63, wid = __builtin_amdgcn_readfirstlane(tid >> 6), r32 = lane & 31, hi = lane >> 5;
    const int g = vcu & 3, tslab = wid & 3, chalf = wid >> 2, t0 = 32 * tslab;
    const int nks = (tslab < 2) ? 4 : 8;
    bf16x8 wa[8];
#pragma unroll
    for (int ks = 0; ks < 8; ++ks) { const float* wp = w_s + ((size_t)(g * 128 + t0 + r32)) * 128 + 16 * ks + 8 * hi; const f32x4 a = *(const f32x4*)wp, b = *(const f32x4*)(wp + 4);
        v4u w; w.x = pk2(a.x, a.y); w.y = pk2(a.z, a.w); w.z = pk2(b.x, b.y); w.w = pk2(b.z, b.w); wa[ks] = __builtin_bit_cast(bf16x8, w); }
    float bs[16];
#pragma unroll
    for (int r = 0; r < 16; ++r) bs[r] = b_s[g * 128 + t0 + crow(r, hi)];
    const int lrow = lane >> 4, c0 = 16 * (lane & 15);
    f32x4 lg[4], lb[4];
#pragma unroll
    for (int j = 0; j < 4; ++j) { lg[j] = *(const f32x4*)(ln_g + g * 256 + c0 + 4 * j); lb[j] = *(const f32x4*)(ln_b + g * 256 + c0 + 4 * j); }
    const unsigned tra = (unsigned)(8 * hi + ((lane & 15) >> 2)) * VP + (unsigned)(16 * ((lane >> 4) & 1) + 4 * (lane & 3)) * 2;
    v4u va[4], vb[4];
    { const size_t R0 = (size_t)(vcu >> 2) * 128;
#pragma unroll
      for (int it = 0; it < 4; ++it) { const bf16* vp = VG + (R0 + 16 * wid + 4 * it + lrow) * 1024 + g * 256 + c0; va[it] = *(const GAS v4u*)vp; vb[it] = *(const GAS v4u*)(vp + 8); } }
    for (int blk = (vcu >> 2); blk < M / 128; blk += (G >> 2)) {
        const size_t R0 = (size_t)blk * 128;
#pragma unroll
        for (int it = 0; it < 4; ++it) {
            const int row = 16 * wid + 4 * it + lrow;
            const v4u a = va[it], b = vb[it];
            float x[16] = { bflo(a.x), bfhi(a.x), bflo(a.y), bfhi(a.y), bflo(a.z), bfhi(a.z), bflo(a.w), bfhi(a.w), bflo(b.x), bfhi(b.x), bflo(b.y), bfhi(b.y), bflo(b.z), bfhi(b.z), bflo(b.w), bfhi(b.w) };
            float s = 0.f;
#pragma unroll
            for (int e = 0; e < 16; ++e) s += x[e];
            s += __shfl_xor(s, 1); s += __shfl_xor(s, 2); s += __shfl_xor(s, 4); s += __shfl_xor(s, 8);
            const float mean = s * (1.f / 256.f); float q = 0.f;
#pragma unroll
            for (int e = 0; e < 16; ++e) { x[e] -= mean; q += x[e] * x[e]; }
            q += __shfl_xor(q, 1); q += __shfl_xor(q, 2); q += __shfl_xor(q, 4); q += __shfl_xor(q, 8);
            const float rstd = 1.0f / sqrtf(q * (1.f / 256.f) + EPS);
            float y[16];
#pragma unroll
            for (int j = 0; j < 4; ++j)
#pragma unroll
                for (int e = 0; e < 4; ++e) y[4 * j + e] = x[4 * j + e] * rstd * lg[j][e] + lb[j][e];
            v4u o0, o1; o0.x = pk2(y[0], y[1]); o0.y = pk2(y[2], y[3]); o0.z = pk2(y[4], y[5]); o0.w = pk2(y[6], y[7]); o1.x = pk2(y[8], y[9]); o1.y = pk2(y[10], y[11]); o1.z = pk2(y[12], y[13]); o1.w = pk2(y[14], y[15]);
            LAS unsigned char* dp = lds + OFF_V + row * VP + c0 * 2;
            *(LAS v4u*)dp = o0; *(LAS v4u*)(dp + 16) = o1;
        }
        __syncthreads();
        v4u ur[8];
#pragma unroll
        for (int it = 0; it < 8; ++it) { const int id = tid + 512 * it, row = id >> 5, ch = id & 31; ur[it] = *(const GAS v4u*)(U + (R0 + row) * 1024 + g * 256 + ch * 8); }
        { const int nb = blk + (G >> 2); const size_t Rn = (size_t)(nb < M / 128 ? nb : blk) * 128;
#pragma unroll
          for (int it = 0; it < 4; ++it) { const bf16* vp = VG + (Rn + 16 * wid + 4 * it + lrow) * 1024 + g * 256 + c0; va[it] = *(const GAS v4u*)vp; vb[it] = *(const GAS v4u*)(vp + 8); } }
#pragma unroll 1
        for (int cb = 0; cb < 4; ++cb) {
            const int cblk = chalf * 4 + cb;
            f32x16 acc = {0.f, 0.f, 0.f, 0.f, 0.f, 0.f, 0.f, 0.f, 0.f, 0.f, 0.f, 0.f, 0.f, 0.f, 0.f, 0.f};
            const LAS unsigned char* bp = lds + OFF_V + tra + cblk * 64;
#pragma unroll
            for (int ks = 0; ks < 8; ++ks) {
                if (ks < nks) {
                    const s16x4 lo = __builtin_bit_cast(s16x4, __builtin_amdgcn_ds_read_tr16_b64_v4i16((LAS s16x4*)(bp + ks * 16 * VP)));
                    const s16x4 h4 = __builtin_bit_cast(s16x4, __builtin_amdgcn_ds_read_tr16_b64_v4i16((LAS s16x4*)(bp + ks * 16 * VP + 4 * VP)));
                    const bf16x8 bfr = (bf16x8){lo[0], lo[1], lo[2], lo[3], h4[0], h4[1], h4[2], h4[3]};
                    acc = __builtin_amdgcn_mfma_f32_32x32x16_bf16(wa[ks], bfr, acc, 0, 0, 0);
                }
            }
#pragma unroll
            for (int r = 0; r < 16; ++r) *(LAS unsigned short*)(lds + OFF_S + (t0 + crow(r, hi)) * SP + (32 * cblk + r32) * 2) = (unsigned short)f2bf(acc[r] + bs[r]);
        }
        __syncthreads();
#pragma unroll
        for (int it = 0; it < 8; ++it) {
            const int id = tid + 512 * it, row = id >> 5, ch = id & 31;
            const v4u sm = *(const LAS v4u*)(lds + OFF_S + row * SP + ch * 16);
            bf16* up = U + (R0 + row) * 1024 + g * 256 + ch * 8;
            const v4u uu = ur[it];
            v4u o; o.x = pk2(bflo(uu.x) * bflo(sm.x), bfhi(uu.x) * bfhi(sm.x)); o.y = pk2(bflo(uu.y) * bflo(sm.y), bfhi(uu.y) * bfhi(sm.y));
            o.z = pk2(bflo(uu.z) * bflo(sm.z), bfhi(uu.z) * bfhi(sm.z)); o.w = pk2(bflo(uu.w) * bflo(sm.w), bfhi(uu.w) * bfhi(sm.w));
            if (!DRY || o.x == 0x12345678u) *(GAS v4u*)up = o;
        }
    }
    __syncthreads();
}
}

namespace sb {
constexpr int KP = 1040;
constexpr int VP = 192;
constexpr int KBYTES = 8448, VBYTES = 64 * VP;
constexpr int OFF_K = 0, OFF_V = 2 * KBYTES, OFF_F = OFF_V + 2 * VBYTES;
constexpr float R_STOP = 3.552713678800501e-15f;
__device__ __forceinline__ int crow(int r, int hi) { return (r & 3) + 8 * (r >> 2) + 4 * hi; }

template <bool MASKED> __device__ __forceinline__ float scan(f32x16& p0, f32x16& p1, int jlim) {
    float run = 1.f;
#pragma unroll
    for (int j = 31; j >= 0; --j) {
        const float z = (j < 16) ? p0[j & 15] : p1[j & 15];
        float r = __builtin_amdgcn_rcpf(1.0f + __builtin_amdgcn_exp2f(z));
        if (MASKED) r = (j < jlim) ? r : 1.0f;
        const float t = r * run, w = run - t;
        if (j < 16) p0[j & 15] = w; else p1[j & 15] = w;
        run = t;
    }
    return run;
}

typedef float f32x2s __attribute__((ext_vector_type(2)));
template <bool MASKED> __device__ __forceinline__ void scan2(f32x16& p0, f32x16& p1, int jlim, int hi, float& R) {
    float r[32];
#pragma unroll
    for (int j = 0; j < 32; ++j) { float e = __builtin_amdgcn_exp2f((j < 16) ? p0[j & 15] : p1[j & 15]); if (MASKED) e = (j < jlim) ? e : 0.f; if (j < 16) p0[j & 15] = e; else p1[j & 15] = e; }
#pragma unroll
    for (int j = 0; j < 32; j += 2) {
        const f32x2s e = (j < 16) ? (f32x2s){p0[j & 15], p0[(j & 15) + 1]} : (f32x2s){p1[j & 15], p1[(j & 15) + 1]};
        const f32x2s d = e + 1.0f;
        r[j] = __builtin_amdgcn_rcpf(d.x); r[j + 1] = __builtin_amdgcn_rcpf(d.y);
        const f32x2s bt = 1.0f - (f32x2s){r[j], r[j + 1]};
        if (j < 16) { p0[j & 15] = bt.x; p0[(j & 15) + 1] = bt.y; } else { p1[j & 15] = bt.x; p1[(j & 15) + 1] = bt.y; }
    }
    f32x2s t8[8];
#pragma unroll
    for (int i = 0; i < 8; ++i) t8[i] = (f32x2s){r[4 * i], r[4 * i + 1]} * (f32x2s){r[4 * i + 2], r[4 * i + 3]};
#pragma unroll
    for (int i = 0; i < 4; ++i) t8[i] = t8[2 * i] * t8[2 * i + 1];
    t8[0] = t8[0] * t8[1]; t8[2] = t8[2] * t8[3];
    const f32x2s tt = t8[0] * t8[2];
    const float T = tt.x * tt.y;
    const float Tp = __shfl_xor(T, 32);
    float run = hi ? R : R * Tp;
    R = R * T * Tp;
#pragma unroll
    for (int j = 31; j >= 0; --j) { const float nx = run * r[j]; r[j] = run; run = nx; }
#pragma unroll
    for (int j = 0; j < 32; j += 2) {
        const f32x2s bt = (j < 16) ? (f32x2s){p0[j & 15], p0[(j & 15) + 1]} : (f32x2s){p1[j & 15], p1[(j & 15) + 1]};
        const f32x2s w = bt * (f32x2s){r[j], r[j + 1]};
        if (j < 16) { p0[j & 15] = w.x; p0[(j & 15) + 1] = w.y; } else { p1[j & 15] = w.x; p1[(j & 15) + 1] = w.y; }
    }
}

template <bool DRY> __device__ __forceinline__ void unit(LAS unsigned char* lds, int b, int h, int qb, bf16* Q, const bf16* K, const bf16* V) {
    const int tid = threadIdx.x, lane = tid & 63, wid = __builtin_amdgcn_readfirstlane(tid >> 6), r32 = lane & 31, hi = lane >> 5;
    const size_t rb = (size_t)b * SEQ;
    const int q0 = qb * 256, qw0 = q0 + 32 * wid, myq = qw0 + r32;
    const int ktd = 4 * qb + (wid >> 1);
    bf16x8 qr[4];
    { const bf16* Qw = Q + (rb + qw0 + r32) * 1024 + h * 64 + hi * 8;
#pragma unroll
      for (int d0 = 0; d0 < 4; ++d0) qr[d0] = *(const GAS bf16x8*)(Qw + d0 * 16); }
    const int skey = tid >> 3, sch = tid & 7;
    const bf16* Kg = K + (rb + skey) * 1024 + h * 64 + sch * 8;
    const bf16* Vg = V + (rb + skey) * 1024 + h * 64 + sch * 8;
    const unsigned ksw = (unsigned)(sch * KP + skey * 16), vsw = (unsigned)(skey * VP + sch * 16);
    const int pk = 32 * ((r32 >> 2) & 1) + (r32 & 3) + 4 * (r32 >> 3);
    const unsigned kra = (unsigned)(hi * KP + pk * 16);
    const unsigned vra = (unsigned)((32 * hi + ((lane & 15) >> 2)) * VP + (16 * ((lane >> 4) & 1) + 4 * (lane & 3)) * 2);
    volatile LAS unsigned* flags = (volatile LAS unsigned*)(lds + OFF_F);
    f32x16 o0 = {0.f, 0.f, 0.f, 0.f, 0.f, 0.f, 0.f, 0.f, 0.f, 0.f, 0.f, 0.f, 0.f, 0.f, 0.f, 0.f}, o1 = o0;
    float R = 1.f; bool alive = true;
    int kt = 4 * qb + 3, buf = 0;
    v4u kreg = *(const GAS v4u*)(Kg + (size_t)kt * 64 * 1024), vreg = *(const GAS v4u*)(Vg + (size_t)kt * 64 * 1024);
    v4u k1 = *(const GAS v4u*)(Kg + (size_t)(kt > 0 ? kt - 1 : 0) * 64 * 1024), v1 = *(const GAS v4u*)(Vg + (size_t)(kt > 0 ? kt - 1 : 0) * 64 * 1024);
    *(LAS v4u*)(lds + OFF_K + ksw) = kreg; *(LAS v4u*)(lds + OFF_V + vsw) = vreg;
    __syncthreads();
    for (;;) {
        const bool has_next = kt > 0;
        const int kt2 = kt > 1 ? kt - 2 : 0;
        const v4u k2 = *(const GAS v4u*)(Kg + (size_t)kt2 * 64 * 1024), v2 = *(const GAS v4u*)(Vg + (size_t)kt2 * 64 * 1024);
        if (kt <= ktd && alive) {
            const LAS unsigned char* Kb = lds + OFF_K + buf * KBYTES + kra;
            const LAS unsigned char* Vb = lds + OFF_V + buf * VBYTES + vra;
            f32x16 p0 = {0.f, 0.f, 0.f, 0.f, 0.f, 0.f, 0.f, 0.f, 0.f, 0.f, 0.f, 0.f, 0.f, 0.f, 0.f, 0.f}, p1 = p0;
#pragma unroll
            for (int d0 = 0; d0 < 4; ++d0) {
                const bf16x8 ka = *(const LAS bf16x8*)(Kb + d0 * 2 * KP), kb = *(const LAS bf16x8*)(Kb + d0 * 2 * KP + 256);
                p0 = __builtin_amdgcn_mfma_f32_32x32x16_bf16(ka, qr[d0], p0, 0, 0, 0);
                p1 = __builtin_amdgcn_mfma_f32_32x32x16_bf16(kb, qr[d0], p1, 0, 0, 0);
            }
            if (kt == ktd) scan2<true>(p0, p1, myq - (64 * kt + 32 * hi), hi, R); else scan2<false>(p0, p1, 64, hi, R);
            bf16x8 pa[4];
            { v4u w;
              w.x = pg8::cvt_pk_bf16(p0[0], p0[1]); w.y = pg8::cvt_pk_bf16(p0[2], p0[3]); w.z = pg8::cvt_pk_bf16(p0[4], p0[5]); w.w = pg8::cvt_pk_bf16(p0[6], p0[7]); pa[0] = __builtin_bit_cast(bf16x8, w);
              w.x = pg8::cvt_pk_bf16(p0[8], p0[9]); w.y = pg8::cvt_pk_bf16(p0[10], p0[11]); w.z = pg8::cvt_pk_bf16(p0[12], p0[13]); w.w = pg8::cvt_pk_bf16(p0[14], p0[15]); pa[1] = __builtin_bit_cast(bf16x8, w);
              w.x = pg8::cvt_pk_bf16(p1[0], p1[1]); w.y = pg8::cvt_pk_bf16(p1[2], p1[3]); w.z = pg8::cvt_pk_bf16(p1[4], p1[5]); w.w = pg8::cvt_pk_bf16(p1[6], p1[7]); pa[2] = __builtin_bit_cast(bf16x8, w);
              w.x = pg8::cvt_pk_bf16(p1[8], p1[9]); w.y = pg8::cvt_pk_bf16(p1[10], p1[11]); w.z = pg8::cvt_pk_bf16(p1[12], p1[13]); w.w = pg8::cvt_pk_bf16(p1[14], p1[15]); pa[3] = __builtin_bit_cast(bf16x8, w); }
#pragma unroll
            for (int j = 0; j < 4; ++j) {
                const s16x4 a0 = __builtin_bit_cast(s16x4, __builtin_amdgcn_ds_read_tr16_b64_v4i16((LAS s16x4*)(Vb + j * 8 * VP)));
                const s16x4 a1 = __builtin_bit_cast(s16x4, __builtin_amdgcn_ds_read_tr16_b64_v4i16((LAS s16x4*)(Vb + j * 8 * VP + 4 * VP)));
                const s16x4 b0 = __builtin_bit_cast(s16x4, __builtin_amdgcn_ds_read_tr16_b64_v4i16((LAS s16x4*)(Vb + j * 8 * VP + 64)));
                const s16x4 b1 = __builtin_bit_cast(s16x4, __builtin_amdgcn_ds_read_tr16_b64_v4i16((LAS s16x4*)(Vb + j * 8 * VP + 4 * VP + 64)));
                o0 = __builtin_amdgcn_mfma_f32_32x32x16_bf16(pa[j], (bf16x8){a0[0], a0[1], a0[2], a0[3], a1[0], a1[1], a1[2], a1[3]}, o0, 0, 0, 0);
                o1 = __builtin_amdgcn_mfma_f32_32x32x16_bf16(pa[j], (bf16x8){b0[0], b0[1], b0[2], b0[3], b1[0], b1[1], b1[2], b1[3]}, o1, 0, 0, 0);
            }
            alive = __any(R > R_STOP);
        }
        if (has_next) { *(LAS v4u*)(lds + OFF_K + (buf ^ 1) * KBYTES + ksw) = k1; *(LAS v4u*)(lds + OFF_V + (buf ^ 1) * VBYTES + vsw) = v1; }
        k1 = k2; v1 = v2;
        if (lane == 0) flags[buf * 8 + wid] = alive ? 1u : 0u;
        asm volatile("s_waitcnt lgkmcnt(0)" ::: "memory"); __builtin_amdgcn_s_barrier(); asm volatile("" ::: "memory");
        if (!has_next) break;
        unsigned any = 0u;
#pragma unroll
        for (int w = 0; w < 8; ++w) any |= flags[buf * 8 + w];
        if (!any) break;
        --kt; buf ^= 1;
    }
    bf16* Ow = Q + (rb + qw0) * 1024 + h * 64 + r32;
#pragma unroll
    for (int r = 0; r < 16; ++r) { bf16* op = Ow + (size_t)crow(r, hi) * 1024; if (!DRY || o0[r] == 12345.678f) { op[0] = (bf16)f2bf(o0[r]); op[32] = (bf16)f2bf(o1[r]); } }
    __syncthreads();
}
template <bool DRY> __device__ __forceinline__ void phase(LAS unsigned char* lds, bf16* Q, const bf16* K, const bf16* V, int vcu, int G) {
    for (int u = vcu; u < BATCH * 16 * 8; u += G) { const int bh = u >> 3, qb = u & 7; unit<DRY>(lds, bh >> 4, bh & 15, qb, Q, K, V); }
}
}

typedef GAS unsigned gu32;
#define XB_TMO      128
#define XB_XCNT(j)  (256  + 64 * (j))
#define XB_XSUB(j)  (1280 + 64 * (j))
#define XB_XGEN(j)  (2304 + 64 * (j))
#define XB_TOP      3328
#define XB_TOPGEN   3392
#define XCD_BAR_WORDS 3456
#define XB_SPIN_CAP (1u << 18)

__device__ __forceinline__ unsigned xb_ld(unsigned* p)              { return __hip_atomic_load(p, __ATOMIC_RELAXED, __HIP_MEMORY_SCOPE_AGENT); }
__device__ __forceinline__ unsigned xb_add(unsigned* p, unsigned v) { return __hip_atomic_fetch_add(p, v, __ATOMIC_RELAXED, __HIP_MEMORY_SCOPE_AGENT); }
__device__ __forceinline__ unsigned xb_xcc_id() { return (unsigned)__builtin_amdgcn_s_getreg((3 << 11) | 20) & 0xFu; }
#define XB_SPIN(cond, bar) do { unsigned _sp = 0; while (cond) { __builtin_amdgcn_s_sleep(1); \
    if ((++_sp & 255u) == 0u) { if (xb_ld(&(bar)[XB_TMO])) break; if (_sp > XB_SPIN_CAP) { atomicAdd(&(bar)[XB_TMO], 1u); break; } } } } while (0)

struct XcdBarrier {
    unsigned* bar; unsigned x;
    volatile LAS unsigned* st;
};

__device__ __forceinline__ XcdBarrier xcd_barrier_post(unsigned* bar, volatile LAS unsigned* st) {
    XcdBarrier b; b.bar = bar; b.x = xb_xcc_id(); b.st = st;
    if (threadIdx.x == 0) (void)xb_add(&bar[XB_XCNT(b.x)], 1u);
    return b;
}
__device__ __forceinline__ void xcd_barrier_complete(unsigned* bar, unsigned x, unsigned& nloc, unsigned& nx) {
    const unsigned G = gridDim.x * gridDim.y * gridDim.z;
    unsigned sum, cnt, mine, sp = 0u;
    for (;;) {
        sum = 0u; cnt = 0u; mine = 0u;
#pragma unroll
        for (unsigned j = 0; j < 16; ++j) { const unsigned c = xb_ld(&bar[XB_XCNT(j)]); sum += c; cnt += (c > 0u) ? 1u : 0u; mine = (j == x) ? c : mine; }
        if (sum == G) break;
        __builtin_amdgcn_s_sleep(1);
        if ((++sp & 255u) == 0u) { if (xb_ld(&bar[XB_TMO])) break; if (sp > XB_SPIN_CAP) { atomicAdd(&bar[XB_TMO], 1u); break; } }
    }
    nloc = mine > 0u ? mine : 1u; nx = cnt > 0u ? cnt : 1u;
}

__device__ __forceinline__ void xcd_barrier(const XcdBarrier& b) {
    asm volatile("s_waitcnt vmcnt(0)" ::: "memory");
    __syncthreads();
    if (threadIdx.x == 0) {
        unsigned* bar = b.bar;
        __builtin_amdgcn_s_waitcnt(0);
        unsigned nloc = b.st[0], nx = b.st[1];
        if (nloc == 0u) { xcd_barrier_complete(bar, b.x, nloc, nx); b.st[0] = nloc; b.st[1] = nx; }
        const unsigned old = xb_add(&bar[XB_XSUB(b.x)], 1u);
        const unsigned gen = old / nloc;
        if (old + 1u == (gen + 1u) * nloc) {
            __builtin_amdgcn_fence(__ATOMIC_RELEASE, "agent");
            asm volatile("s_waitcnt vmcnt(0)" ::: "memory");
            const unsigned og = xb_add(&bar[XB_TOP], 1u);
            const unsigned tg = og / nx;
            if (og + 1u == (tg + 1u) * nx) xb_add(&bar[XB_TOPGEN], 1u);
            else XB_SPIN(xb_ld(&bar[XB_TOPGEN]) == tg, bar);
            __builtin_amdgcn_fence(__ATOMIC_ACQUIRE, "agent");
            xb_add(&bar[XB_XGEN(b.x)], 1u);
            asm volatile("s_waitcnt vmcnt(0)" ::: "memory");
        } else {
            XB_SPIN(xb_ld(&bar[XB_XGEN(b.x)]) == gen, bar);
            __builtin_amdgcn_fence(__ATOMIC_ACQUIRE, "agent");
            asm volatile("s_waitcnt vmcnt(0)" ::: "memory");
        }
    }
    __syncthreads();
}

struct Args { const float* in[20]; float* out; unsigned char* ws; };
__global__ void __launch_bounds__(NTHREADS, 2) mk_fwd(Args args) {
    extern __shared__ __attribute__((aligned(16))) unsigned char lds_raw[];
    LAS unsigned char* lds = (LAS unsigned char*)lds_raw;
    cg::grid_group grid = cg::this_grid();
    const int tid = threadIdx.x, lane = tid & 63, wave = __builtin_amdgcn_readfirstlane(tid >> 6);
    const int G = gridDim.x, bx = blockIdx.x, vcu = (G % 8 == 0) ? (bx % 8) * (G / 8) + bx / 8 : bx;
    const int gw = vcu * NWAVES + wave, NGW = G * NWAVES;
    unsigned char* ws = args.ws;
    volatile LAS unsigned* xst = (volatile LAS unsigned*)(lds + LDS_BYTES - 64);
    if (tid < 2) xst[tid] = 0u;
    unsigned* barw = (unsigned*)ws;
    unsigned* pcnt = (unsigned*)(ws + 16384);
    const XcdBarrier xb = xcd_barrier_post(barw, xst);
    float* xbuf = (float*)(ws + WS_XBUF); float *rstd1 = xbuf + (size_t)M * 4, *rstd2 = rstd1 + M, *rstd0 = rstd2 + M;
    LAS unsigned char* tl = lds + 131072;
    const float* x = args.in[0];
    float* out = args.out;
    bf16 *Wgu1 = (bf16*)(ws + WS_WGU1), *Wd1 = (bf16*)(ws + WS_WD1), *Win = (bf16*)(ws + WS_WIN), *WA = (bf16*)(ws + WS_WA), *WB = (bf16*)(ws + WS_WB), *Wout = (bf16*)(ws + WS_WOUT),
         *Wgu2 = (bf16*)(ws + WS_WGU2), *Wd2 = (bf16*)(ws + WS_WD2);
    bf16 *XN = (bf16*)(ws + WS_XN), *UB = (bf16*)(ws + WS_U), *VG = (bf16*)(ws + WS_VG), *QB = (bf16*)(ws + WS_Q), *KB = (bf16*)(ws + WS_K), *VB = (bf16*)(ws + WS_V), *GB = (bf16*)(ws + WS_GB), *HB = (bf16*)(ws + WS_H);

    {
        LAS float* scr = (LAS float*)(lds + wave * 16384);
        constexpr int I_GU = (D / 64) * (FF / 32), I_DN = (FF / 64) * (D / 32), I_IN = (D / 64) * (DIN / 32), I_SQ = (D / 64) * (D / 32);
        constexpr int NITEMS = 4 * I_GU + 2 * I_DN + I_IN + 3 * I_SQ;
        for (int it = gw; it < NITEMS; it += NGW) {
            int r = it;
            if (r < I_GU) { p0_transpose_item(args.in[2], D, FF, Wgu1, 1, args.in[1], scr, r, lane); continue; } r -= I_GU;
            if (r < I_GU) { p0_transpose_item(args.in[3], D, FF, Wgu1, 2, args.in[1], scr, r, lane); continue; } r -= I_GU;
            if (r < I_DN) { p0_transpose_item(args.in[4], FF, D, Wd1, 0, nullptr, scr, r, lane); continue; } r -= I_DN;
            if (r < I_IN) { p0_transpose_item(args.in[6], D, DIN, Win, 0, args.in[5], scr, r, lane); continue; } r -= I_IN;
            if (r < I_SQ) { p0_transpose_item(args.in[12], D, D, WA, 0, nullptr, scr, r, lane); continue; } r -= I_SQ;
            if (r < I_SQ) { p0_transpose_item(args.in[13], D, D, WB, 0, nullptr, scr, r, lane); continue; } r -= I_SQ;
            if (r < I_SQ) { p0_transpose_item(args.in[14], D, D, Wout, 0, nullptr, scr, r, lane); continue; } r -= I_SQ;
            if (r < I_GU) { p0_transpose_item(args.in[16], D, FF, Wgu2, 1, args.in[15], scr, r, lane); continue; } r -= I_GU;
            if (r < I_GU) { p0_transpose_item(args.in[17], D, FF, Wgu2, 2, args.in[15], scr, r, lane); continue; } r -= I_GU;
            p0_transpose_item(args.in[18], FF, D, Wd2, 0, nullptr, scr, r, lane);
        }
        rms_rows<false>(x, nullptr, XN, rstd0, gw, NGW, lane);
    }
    xcd_barrier(xb);
    if (G == 0x7fffffff) grid.sync();
    { pg8::Gemm g{XN, Wgu1, M, NGU, D}; pg8::StaticOrder S; S.init(M, NGU, G, bx); pg8::EpiSwiglu E{HB, FF};
      pg8::gemm_phase<pg8::EpiSwiglu, pg8::StaticOrder, true, true, true>(lds, g, S, E); }
    xcd_barrier(xb);
    { pg8::Gemm g{HB, Wd1, M, D, FF}; pg8::StaticOrder S; S.init(M, D, G, bx); pg8::EpiResidNorm<0, true> E{XN, rstd0, XN, rstd1, 0.5f, xbuf, pcnt, tl};
      pg8::gemm_phase<pg8::EpiResidNorm<0, true>, pg8::StaticOrder, true, true>(lds, g, S, E); }
    xcd_barrier(xb);
    bf16 *KO = (bf16*)out, *VO = KO + (size_t)M * 1024, *GA = KB;
    { pg8::Gemm g{XN, Win, M, 2048, D}; pg8::StaticOrder S; S.init(M, 2048, G, bx); pg8::EpiProj<0> E{UB, VG, nullptr, nullptr, nullptr, nullptr, 1.f};
      pg8::gemm_phase<pg8::EpiProj<0>, pg8::StaticOrder, true, true, true>(lds, g, S, E); }
    { pg8::Gemm g{XN, Win + (size_t)2048 * D, M, 5120, D}; pg8::StaticOrder S; S.init(M, 5120, G, bx); pg8::EpiProj<1> E{QB, KO, VO, GA, GB, args.in[7], QSCALE};
      pg8::gemm_phase<pg8::EpiProj<1>, pg8::StaticOrder, true, true, true>(lds, g, S, E); }
    xcd_barrier(xb);
    gm::phase<false>(lds, UB, VG, args.in[8], args.in[9], args.in[10], args.in[11], vcu, G);
    sb::phase<false>(lds, QB, KO, VO, vcu, G);
    xcd_barrier(xb);
    { pg8::Gemm g{UB, WA, M, D, D}; pg8::StaticOrder S; S.init(M, D, G, bx); pg8::EpiGate<false> E{GA, nullptr, GA};
      pg8::gemm_phase<pg8::EpiGate<false>, pg8::StaticOrder, true, true>(lds, g, S, E); }
    { pg8::Gemm g{QB, WB, M, D, D}; pg8::StaticOrder S; S.init(M, D, G, bx); pg8::EpiGate<true> E{GB, GA, GB};
      pg8::gemm_phase<pg8::EpiGate<true>, pg8::StaticOrder, true, true>(lds, g, S, E); }
    xcd_barrier(xb);
    { pg8::Gemm g{GB, Wout, M, D, D}; pg8::StaticOrder S; S.init(M, D, G, bx); pg8::EpiResidNorm<0, true> E{XN, rstd1, XN, rstd2, 1.0f, xbuf, pcnt + 4096, tl};
      pg8::gemm_phase<pg8::EpiResidNorm<0, true>, pg8::StaticOrder, true, true>(lds, g, S, E); }
    xcd_barrier(xb);
    { pg8::Gemm g{XN, Wgu2, M, NGU, D}; pg8::StaticOrder S; S.init(M, NGU, G, bx); pg8::EpiSwiglu E{HB, FF};
      pg8::gemm_phase<pg8::EpiSwiglu, pg8::StaticOrder, true, true, true>(lds, g, S, E); }
    xcd_barrier(xb);
    { pg8::Gemm g{HB, Wd2, M, D, FF}; pg8::StaticOrder S; S.init(M, D, G, bx); pg8::EpiResidNorm<1, true> E{XN, rstd2, out, (float*)args.in[19], 0.5f, xbuf, pcnt + 8192, tl};
      pg8::gemm_phase<pg8::EpiResidNorm<1, true>, pg8::StaticOrder, true, true>(lds, g, S, E); }
}

extern "C" void kernel_launch(void* const* d_in, const int* in_sizes, int n_in, void* d_out, int out_size, void* d_ws, size_t ws_size, hipStream_t stream) {
    static int grid = 0;
    if (grid == 0) {
        if (n_in != 20 || in_sizes[0] != M * D || out_size != M * D || ws_size < WS_END) { fprintf(stderr, "kernel_launch: unexpected shapes / workspace (n_in %d, ws %zu)\n", n_in, ws_size); grid = -1; return; }
        int dev = 0, cus = 0, per_cu = 0;
        if (hipGetDevice(&dev) != hipSuccess || hipDeviceGetAttribute(&cus, hipDeviceAttributeMultiprocessorCount, dev) != hipSuccess) { grid = -1; return; }
        if (hipFuncSetAttribute((const void*)mk_fwd, hipFuncAttributeMaxDynamicSharedMemorySize, LDS_BYTES) != hipSuccess) { fprintf(stderr, "kernel_launch: hipFuncSetAttribute failed\n"); grid = -1; return; }
        if (hipOccupancyMaxActiveBlocksPerMultiprocessor(&per_cu, (const void*)mk_fwd, NTHREADS, LDS_BYTES) != hipSuccess || per_cu < 1) { fprintf(stderr, "kernel_launch: occupancy query says %d\n", per_cu); per_cu = 1; }
        (void)hipGetLastError();
        grid = cus;
    }
    if (grid < 0) return;
    Args a{};
    for (int i = 0; i < 20; ++i) a.in[i] = (const float*)d_in[i];
    a.out = (float*)d_out; a.ws = (unsigned char*)d_ws;
    if (hipMemsetAsync(d_ws, 0, 65536, stream) != hipSuccess) { fprintf(stderr, "kernel_launch: hipMemsetAsync of the control words failed\n"); return; }
    void* kargs[] = {&a};
    hipError_t e = hipLaunchCooperativeKernel((const void*)mk_fwd, dim3(grid), dim3(NTHREADS), kargs, LDS_BYTES, stream);
    if (e != hipSuccess) fprintf(stderr, "kernel_launch: cooperative launch failed: %s (grid %d)\n", hipGetErrorString(e), grid);
}
```
